# Optimizing an MI355X kernel written in HIP

```python
import math
import jax, jax.numpy as jnp
from jax import lax
import numpy as np

D_MODEL = 1024
BATCH = 4
SEQ = 4096
DEPTH = 2
DEC_BATCH = 32
DEC_SEQ = 16
PAST_LEN = 4096

CHUNK = 64
N_A_LAYERS = max(1, DEPTH // 2)
N_B_LAYERS = DEPTH - N_A_LAYERS
RMS_EPS = 1e-6
FFN_DIM = 2816
FFN_RES = 0.5
MLA_HEADS = 16
MLA_Q_LORA = 384
MLA_KV_LORA = 256
MLA_NOPE = 64
MLA_ROPE = 32
MLA_V = 64
ROPE_BASE = 10000.0
Q_BLOCK = 128
SWA_HEADS = 16
SWA_KV_HEADS = 4
SWA_HEAD_DIM = 64
SWA_REP = SWA_HEADS // SWA_KV_HEADS
WINDOW = 128
WINDOW_CHUNKS = WINDOW // CHUNK
N_BUCKETS = 32
MAX_DISTANCE = 128
NEG_INF = -1e30

kernel_name = "yoco_mla_swa_sink_macaron_step"


def rms_norm(x, g):
    xf = x.astype(jnp.float32)
    y = xf * lax.rsqrt(jnp.mean(xf * xf, axis=-1, keepdims=True) + RMS_EPS)
    return (y * g.astype(jnp.float32)).astype(x.dtype)


def swiglu(x, w_gate, w_up, w_down):
    return (jax.nn.silu(x @ w_gate) * (x @ w_up)) @ w_down


def rope_angles(pos):
    inv = ROPE_BASE ** (-jnp.arange(0, MLA_ROPE, 2, dtype=jnp.float32) / MLA_ROPE)
    ang = pos.astype(jnp.float32)[:, None] * inv[None, :]
    return jnp.cos(ang), jnp.sin(ang)


def apply_rope(x, cos, sin):
    xf = x.astype(jnp.float32)
    x1, x2 = jnp.split(xf, 2, axis=-1)
    return jnp.concatenate([x1 * cos - x2 * sin, x1 * sin + x2 * cos], axis=-1).astype(x.dtype)


def rel_bucket(rel):
    half = N_BUCKETS // 2
    max_exact = half // 2
    base = jnp.where(rel > 0, half, 0)
    n = jnp.abs(rel)
    nf = jnp.maximum(n, 1).astype(jnp.float32)
    large = max_exact + (jnp.log(nf / max_exact) / math.log(MAX_DISTANCE / max_exact)
                         * (half - max_exact)).astype(jnp.int32)
    large = jnp.minimum(large, half - 1)
    return base + jnp.where(n < max_exact, n, large)


def relative_bias(rel, table):
    return jnp.moveaxis(table[rel_bucket(rel)].astype(jnp.float32), -1, 0)[None]


def sink_attention(q, k, v, bias, valid, sinks):
    n_blk, _, n_q, n_k = bias.shape
    bias = bias.reshape(n_blk, SWA_KV_HEADS, SWA_REP, n_q, n_k)
    s = jnp.einsum('bnqgrd,bnkgd->bngrqk', q, k).astype(jnp.float32) * (SWA_HEAD_DIM ** -0.5) + bias[None]
    s = jnp.where(valid[None, :, None, None], s, NEG_INF)
    sink = sinks.astype(jnp.float32).reshape(1, 1, SWA_KV_HEADS, SWA_REP, 1, 1)
    m = jnp.maximum(jnp.max(s, axis=-1, keepdims=True), sink)
    p = jnp.exp(s - m)
    p = p / (jnp.sum(p, axis=-1, keepdims=True) + jnp.exp(sink - m))
    return jnp.einsum('bngrqk,bnkgd->bnqgrd', p.astype(v.dtype), v)


def swa_prompt(q, k, v, rel_table, sinks):
    b_, s_, _ = q.shape
    n_chunks = s_ // CHUNK
    pad = WINDOW_CHUNKS * CHUNK
    band_len = pad + CHUNK
    qb = q.reshape(b_, n_chunks, CHUNK, SWA_KV_HEADS, SWA_REP, SWA_HEAD_DIM)

    def band(t):
        t = jnp.pad(t, ((0, 0), (pad, 0), (0, 0), (0, 0)))
        t = t.reshape(b_, n_chunks + WINDOW_CHUNKS, CHUNK, SWA_KV_HEADS, SWA_HEAD_DIM)
        return jnp.concatenate([t[:, j:j + n_chunks] for j in range(WINDOW_CHUNKS + 1)], axis=2)

    off_k = jnp.arange(band_len) - pad
    bias = relative_bias(off_k[None, :] - jnp.arange(CHUNK)[:, None], rel_table)
    kpos = jnp.arange(n_chunks)[:, None] * CHUNK + off_k[None, :]
    valid = (kpos >= 0)[:, None, :]
    o = sink_attention(qb, band(k), band(v), bias, valid, sinks)
    return o.reshape(b_, s_, SWA_HEADS * SWA_HEAD_DIM)


def swa_step(q, k_all, v_all, qpos, kpos, rel_table, sinks):
    b_, s_, _ = q.shape
    qc, kc = qpos // CHUNK, kpos // CHUNK
    valid = ((kc[None, :] <= qc[:, None]) & (kc[None, :] >= qc[:, None] - WINDOW_CHUNKS))[None]
    bias = relative_bias(kpos[None, :] - qpos[:, None], rel_table)
    qb = q.reshape(b_, 1, s_, SWA_KV_HEADS, SWA_REP, SWA_HEAD_DIM)
    o = sink_attention(qb, k_all[:, None], v_all[:, None], bias, valid, sinks)
    return o.reshape(b_, s_, SWA_HEADS * SWA_HEAD_DIM)


def mla_attention(q_lat, q_rope, c_kv, k_rope, qpos, kpos):
    scale = (MLA_NOPE + MLA_ROPE) ** -0.5
    kc = kpos // CHUNK

    def block(args):
        ql, qr, qp = args
        s = (jnp.einsum('bqhc,bkc->bhqk', ql, c_kv)
             + jnp.einsum('bqhr,bkr->bhqk', qr, k_rope)).astype(jnp.float32) * scale
        mask = kc[None, :] <= (qp // CHUNK)[:, None]
        p = jax.nn.softmax(jnp.where(mask[None, None], s, NEG_INF), axis=-1)
        return jnp.einsum('bhqk,bkc->bqhc', p.astype(c_kv.dtype), c_kv)

    sq = q_lat.shape[1]
    if sq > Q_BLOCK:
        nb = sq // Q_BLOCK
        split = lambda t: jnp.moveaxis(t.reshape(t.shape[0], nb, Q_BLOCK, *t.shape[2:]), 1, 0)
        out = lax.map(block, (split(q_lat), split(q_rope), qpos.reshape(nb, Q_BLOCK)))
        return jnp.moveaxis(out, 0, 1).reshape(q_lat.shape)
    return block((q_lat, q_rope, qpos))


def mla_mixer(h, pos, past_len, cache_lat, cache_rope, w_dq, q_norm, w_uq, w_dkv, kv_norm, w_uk, w_uv, w_o):
    b_, s_, _ = h.shape
    cq = rms_norm(h @ w_dq, q_norm)
    q = (cq @ w_uq).reshape(b_, s_, MLA_HEADS, MLA_NOPE + MLA_ROPE)
    q_nope, q_rope = q[..., :MLA_NOPE], q[..., MLA_NOPE:]
    ckv = h @ w_dkv
    lat = rms_norm(ckv[..., :MLA_KV_LORA], kv_norm)
    cos, sin = rope_angles(pos)
    k_rope = apply_rope(ckv[..., MLA_KV_LORA:], cos, sin)
    q_rope = apply_rope(q_rope, cos[:, None], sin[:, None])
    q_lat = jnp.einsum('bshn,chn->bshc', q_nope, w_uk)
    if cache_lat is None:
        all_lat, all_rope, kpos = lat, k_rope, pos
    else:
        all_lat = jnp.concatenate([cache_lat, lat], axis=1)
        all_rope = jnp.concatenate([cache_rope, k_rope], axis=1)
        kpos = jnp.arange(past_len + s_)
    o_lat = mla_attention(q_lat, q_rope, all_lat, all_rope, pos, kpos)
    o = jnp.einsum('bshc,chv->bshv', o_lat, w_uv).reshape(b_, s_, MLA_HEADS * MLA_V)
    return o @ w_o, lat, k_rope


def trunk(x, past_len, cache_lat, cache_rope, cache_k, cache_v, P):
    b_, s_, _ = x.shape
    pos = past_len + jnp.arange(s_)
    new_lat, new_rope = [], []
    kv_k = kv_v = None
    for layer in range(DEPTH):
        x = x + FFN_RES * swiglu(rms_norm(x, P['ffn_norm1'][layer]), P['ffn1_w_gate'][layer],
                                 P['ffn1_w_up'][layer], P['ffn1_w_down'][layer])
        h = rms_norm(x, P['mix_norm'][layer])
        if layer < N_A_LAYERS:
            a = layer
            y, lat, kr = mla_mixer(
                h, pos, past_len,
                None if cache_lat is None else cache_lat[a],
                None if cache_rope is None else cache_rope[a],
                P['mla_w_dq'][a], P['mla_q_norm'][a], P['mla_w_uq'][a], P['mla_w_dkv'][a],
                P['mla_kv_norm'][a], P['mla_w_uk'][a], P['mla_w_uv'][a], P['mla_w_o'][a])
            new_lat.append(lat)
            new_rope.append(kr)
        else:
            bl = layer - N_A_LAYERS
            q = h @ P['swa_w_q'][bl]
            if cache_k is None:
                o = swa_prompt(q, kv_k, kv_v, P['rel_bias'], P['swa_sinks'][bl])
            else:
                w_c = cache_k.shape[1]
                k_all = jnp.concatenate([cache_k, kv_k], axis=1)
                v_all = jnp.concatenate([cache_v, kv_v], axis=1)
                kpos = jnp.arange(past_len - w_c, past_len + s_)
                o = swa_step(q, k_all, v_all, pos, kpos, P['rel_bias'], P['swa_sinks'][bl])
            y = o @ P['swa_w_o'][bl]
        x = x + y
        x = x + FFN_RES * swiglu(rms_norm(x, P['ffn_norm2'][layer]), P['ffn2_w_gate'][layer],
                                 P['ffn2_w_up'][layer], P['ffn2_w_down'][layer])
        if layer == N_A_LAYERS - 1:
            kv = (rms_norm(x, P['kv_norm']) @ P['w_kv_shared']).reshape(
                b_, s_, 2, SWA_KV_HEADS, SWA_HEAD_DIM)
            kv_k, kv_v = kv[:, :, 0], kv[:, :, 1]
    y = rms_norm(x, P['final_norm'])
    return y, jnp.stack(new_lat), jnp.stack(new_rope), kv_k, kv_v


def setup_inputs(seed: int = 0) -> dict:
    key = jax.random.key(seed)
    ks = iter(jax.random.split(key, 32))
    nrm = lambda shape, scale: jax.random.normal(next(ks), shape, jnp.float32) * scale
    gain = lambda shape: 1.0 + nrm(shape, 0.02)
    swa_cache = min(WINDOW, PAST_LEN)
    D, F = D_MODEL, FFN_DIM
    return {
        "x_prompt": nrm((BATCH, SEQ, D), 1.0),
        "x_sample": nrm((DEC_BATCH, DEC_SEQ, D), 1.0),
        "cache_mla_latent": nrm((N_A_LAYERS, DEC_BATCH, PAST_LEN, MLA_KV_LORA), 1.0),
        "cache_mla_krope": nrm((N_A_LAYERS, DEC_BATCH, PAST_LEN, MLA_ROPE), 1.0),
        "cache_swa_k": nrm((DEC_BATCH, swa_cache, SWA_KV_HEADS, SWA_HEAD_DIM), 1.0),
        "cache_swa_v": nrm((DEC_BATCH, swa_cache, SWA_KV_HEADS, SWA_HEAD_DIM), 1.0),
        "ffn_norm1": gain((DEPTH, D)),
        "ffn1_w_gate": nrm((DEPTH, D, F), D ** -0.5),
        "ffn1_w_up": nrm((DEPTH, D, F), D ** -0.5),
        "ffn1_w_down": nrm((DEPTH, F, D), F ** -0.5),
        "mix_norm": gain((DEPTH, D)),
        "ffn_norm2": gain((DEPTH, D)),
        "ffn2_w_gate": nrm((DEPTH, D, F), D ** -0.5),
        "ffn2_w_up": nrm((DEPTH, D, F), D ** -0.5),
        "ffn2_w_down": nrm((DEPTH, F, D), F ** -0.5),
        "mla_w_dq": nrm((N_A_LAYERS, D, MLA_Q_LORA), D ** -0.5),
        "mla_q_norm": gain((N_A_LAYERS, MLA_Q_LORA)),
        "mla_w_uq": nrm((N_A_LAYERS, MLA_Q_LORA, MLA_HEADS * (MLA_NOPE + MLA_ROPE)), MLA_Q_LORA ** -0.5),
        "mla_w_dkv": nrm((N_A_LAYERS, D, MLA_KV_LORA + MLA_ROPE), D ** -0.5),
        "mla_kv_norm": gain((N_A_LAYERS, MLA_KV_LORA)),
        "mla_w_uk": nrm((N_A_LAYERS, MLA_KV_LORA, MLA_HEADS, MLA_NOPE), MLA_KV_LORA ** -0.5),
        "mla_w_uv": nrm((N_A_LAYERS, MLA_KV_LORA, MLA_HEADS, MLA_V), MLA_KV_LORA ** -0.5),
        "mla_w_o": nrm((N_A_LAYERS, MLA_HEADS * MLA_V, D), (MLA_HEADS * MLA_V) ** -0.5),
        "kv_norm": gain((D,)),
        "w_kv_shared": nrm((D, 2 * SWA_KV_HEADS * SWA_HEAD_DIM), D ** -0.5),
        "swa_w_q": nrm((N_B_LAYERS, D, SWA_HEADS * SWA_HEAD_DIM), D ** -0.5),
        "swa_sinks": nrm((N_B_LAYERS, SWA_HEADS), 1.0),
        "swa_w_o": nrm((N_B_LAYERS, SWA_HEADS * SWA_HEAD_DIM, D), (SWA_HEADS * SWA_HEAD_DIM) ** -0.5),
        "rel_bias": nrm((N_BUCKETS, SWA_HEADS), 0.3),
        "final_norm": gain((D,)),
    }


def reference(x_prompt, x_sample, cache_mla_latent, cache_mla_krope, cache_swa_k, cache_swa_v,
              ffn_norm1, ffn1_w_gate, ffn1_w_up, ffn1_w_down, mix_norm,
              ffn_norm2, ffn2_w_gate, ffn2_w_up, ffn2_w_down,
              mla_w_dq, mla_q_norm, mla_w_uq, mla_w_dkv, mla_kv_norm, mla_w_uk, mla_w_uv, mla_w_o,
              kv_norm, w_kv_shared, swa_w_q, swa_sinks, swa_w_o, rel_bias, final_norm):
    P = dict(ffn_norm1=ffn_norm1, ffn1_w_gate=ffn1_w_gate, ffn1_w_up=ffn1_w_up, ffn1_w_down=ffn1_w_down,
             mix_norm=mix_norm, ffn_norm2=ffn_norm2, ffn2_w_gate=ffn2_w_gate, ffn2_w_up=ffn2_w_up,
             ffn2_w_down=ffn2_w_down, mla_w_dq=mla_w_dq, mla_q_norm=mla_q_norm, mla_w_uq=mla_w_uq,
             mla_w_dkv=mla_w_dkv, mla_kv_norm=mla_kv_norm, mla_w_uk=mla_w_uk, mla_w_uv=mla_w_uv,
             mla_w_o=mla_w_o, kv_norm=kv_norm, w_kv_shared=w_kv_shared, swa_w_q=swa_w_q,
             swa_sinks=swa_sinks, swa_w_o=swa_w_o, rel_bias=rel_bias, final_norm=final_norm)
    y_prompt, lat_p, rope_p, k_p, v_p = trunk(x_prompt, 0, None, None, None, None, P)
    s_p = x_prompt.shape[1]
    keep = min(WINDOW, s_p)
    new_swa_k_prompt = k_p[:, s_p - keep:]
    new_swa_v_prompt = v_p[:, s_p - keep:]
    past_len = cache_mla_latent.shape[2]
    y_sample, lat_s, rope_s, k_s, v_s = trunk(x_sample, past_len, cache_mla_latent, cache_mla_krope,
                                              cache_swa_k, cache_swa_v, P)
    return (y_prompt, y_sample, lat_p, rope_p, new_swa_k_prompt, new_swa_v_prompt,
            lat_s, rope_s, k_s, v_s)
```

```cpp
#include <hip/hip_runtime.h>
#include <hip/hip_cooperative_groups.h>
#include <cstdio>
#include <cstdint>
#include <cmath>
namespace cg = cooperative_groups;

#define DI __device__ __forceinline__
#define LAS __attribute__((address_space(3)))
typedef unsigned short bf16_t;
typedef short bf16x8 __attribute__((ext_vector_type(8)));
typedef short s16x4 __attribute__((ext_vector_type(4)));
typedef float f32x4 __attribute__((ext_vector_type(4)));
typedef float f32x16 __attribute__((ext_vector_type(16)));
typedef unsigned u32x4 __attribute__((ext_vector_type(4)));
typedef unsigned u32x2 __attribute__((ext_vector_type(2)));
typedef LAS unsigned char lds_u8;

constexpr int DM = 1024, TP = 16384, TS = 512, TT = TP + TS, SEQ = 4096;
constexpr int FF = 2816, FF2 = 5632;
constexpr int QL = 384, KVL = 256, CKVW = 288, QD = 96;
constexpr int KCL = 4112;
constexpr int NWAVES = 8, NTHREADS = 512;
constexpr int LDS_BYTES = 153600;
constexpr int LDS_SLOT = LDS_BYTES - 64;
constexpr float LOG2E = 1.4426950408889634f;
constexpr float RMS_EPS = 1e-6f;

constexpr size_t O_Y = 0;
constexpr size_t O_LATP = (size_t)TT * DM;
constexpr size_t O_ROPEP = O_LATP + (size_t)TP * 256;
constexpr size_t O_KP = O_ROPEP + (size_t)TP * 32;
constexpr size_t O_VP = O_KP + 4 * 128 * 256;
constexpr size_t O_LATS = O_VP + 4 * 128 * 256;
constexpr size_t O_ROPES = O_LATS + (size_t)TS * 256;
constexpr size_t O_KS = O_ROPES + (size_t)TS * 32;
constexpr size_t O_VS = O_KS + (size_t)TS * 256;

constexpr size_t al256(size_t x) { return (x + 255) & ~(size_t)255; }
constexpr size_t WS_CTL = 0, CTL_BYTES = 65536;
constexpr size_t WS_WGU = CTL_BYTES;
constexpr size_t WS_WD = WS_WGU + 4 * (size_t)FF2 * DM * 2;
constexpr size_t WS_W3 = WS_WD + 4 * (size_t)DM * FF * 2;
constexpr size_t WS_WUQT = WS_W3 + 768 * (size_t)DM * 2;
constexpr size_t WS_WABST = WS_WUQT + 1536 * (size_t)QL * 2;
constexpr size_t WS_WUKT = WS_WABST + 4608 * (size_t)QL * 2;
constexpr size_t WS_WUVT = WS_WUKT + 1024 * 256 * 2;
constexpr size_t WS_WOT = WS_WUVT + 1024 * 256 * 2;
constexpr size_t WS_WOVT = WS_WOT + (size_t)DM * DM * 2;
constexpr size_t WS_WKVT = WS_WOVT + (size_t)DM * 4096 * 2;
constexpr size_t WS_WQST = WS_WKVT + 512 * (size_t)DM * 2;
constexpr size_t WS_WOST = WS_WQST + (size_t)DM * DM * 2;
constexpr size_t WS_ROPE = WS_WOST + (size_t)DM * DM * 2;
constexpr size_t WS_BT = WS_ROPE + (size_t)KCL * 32 * 4;
constexpr size_t WS_XB = al256(WS_BT + 16 * 256 * 4);
constexpr size_t WS_SSQX = WS_XB + (size_t)TT * DM * 2;
constexpr size_t WS_SSQQ = WS_SSQX + (size_t)TT * 16 * 4;
constexpr size_t WS_SSQL = WS_SSQQ + (size_t)TT * 16 * 4;
constexpr size_t WS_SSQS = WS_SSQL + (size_t)TT * 16 * 4;
constexpr size_t WS_ACT = WS_SSQS + (size_t)TS * 32 * 4;
constexpr size_t WS_QB = WS_ACT;
constexpr size_t WS_QS = WS_ACT;
constexpr size_t WS_RB = WS_ACT + (size_t)TT * FF * 2;
constexpr size_t WS_CQB = WS_RB;
constexpr size_t WS_CKV = WS_CQB + (size_t)TT * QL * 2;
constexpr size_t WS_LATB = WS_CKV + (size_t)TT * CKVW * 4;
constexpr size_t WS_OB = WS_RB;
static_assert(WS_LATB + (size_t)TP * 256 * 2 >= WS_OB + (size_t)TT * DM * 2, "alias");
constexpr size_t WS_QA = WS_LATB + (size_t)TP * 256 * 2;
constexpr size_t WS_KNV = WS_QA + (size_t)TS * 4608 * 2;
constexpr size_t WS_KRB = WS_KNV + (size_t)TP * 2048 * 2;
constexpr size_t WS_OA = WS_KRB + (size_t)TP * 32 * 2;
constexpr size_t WS_KVSB = WS_OA + (size_t)TS * 4096 * 2;
constexpr size_t WS_KS = WS_KVSB + (size_t)TP * 512 * 2;
constexpr size_t WS_KC = WS_KS + (size_t)32 * 192 * 512 * 2;
constexpr size_t WS_END = WS_KC + (size_t)32 * KCL * CKVW * 2 + 65536;

DI unsigned pk2(float lo, float hi) {
    typedef float f2 __attribute__((ext_vector_type(2))); typedef __bf16 b2 __attribute__((ext_vector_type(2)));
    f2 v = {lo, hi}; b2 b = __builtin_convertvector(v, b2); return __builtin_bit_cast(unsigned, b);
}
DI unsigned short f2bf(float f) { return (unsigned short)(pk2(f, 0.f) & 0xffffu); }
DI float wave_sum(float v) {
#pragma unroll
    for (int o = 1; o < 64; o <<= 1) v += __shfl_xor(v, o);
    return v;
}
DI float row_rstd(const float* ssq, int row, int n4, float inv_dim) {
    const f32x4* p = (const f32x4*)(ssq + (size_t)row * 16);
    float s = 0.f;
    for (int i = 0; i < n4; ++i) { const f32x4 v = p[i]; s += (v.x + v.y) + (v.z + v.w); }
    return rsqrtf(s * inv_dim + RMS_EPS);
}
DI float srow_rstd(const float* ssqs, int rl) { const f32x4* p4 = (const f32x4*)(ssqs + (size_t)rl * 32); float s = 0.f;
#pragma unroll
    for (int i = 0; i < 8; ++i) { const f32x4 v = p4[i]; s += (v.x + v.y) + (v.z + v.w); }
    return rsqrtf(s * (1.0f / DM) + RMS_EPS); }
DI int otid() { int t = threadIdx.x; asm volatile("" : "+v"(t)); return t; }
DI float halfmax(float m) { auto rr = __builtin_amdgcn_permlane32_swap(__float_as_uint(m), __float_as_uint(m), false, false); return fmaxf(__uint_as_float(rr[0]), __uint_as_float(rr[1])); }
DI int crow(int i, int h) { return (i & 3) + 8 * (i >> 2) + 4 * h; }
#define MFMA32(a, b, c) __builtin_amdgcn_mfma_f32_32x32x16_bf16((a), (b), (c), 0, 0, 0)

namespace pg8 {
constexpr int BM = 256, BK = 64, HALF = 128, HTB = HALF * BK * 2, STAGE_BYTES = 8 * HTB, NXCD = 8, WGM = 8;
__host__ __device__ __forceinline__ int lds_byte(int r, int c) { const int st = (r >> 4) * 2 + (c >> 5), rr = r & 15, cc = c & 31, ob = rr * 64 + cc * 2; return st * 1024 + (ob ^ (((ob >> 9) & 1) << 5)); }
__host__ __device__ __forceinline__ void stage_rc(int b, int& R, int& C) { const int st = b / 1024, sb = b % 1024, swz = sb ^ (((sb >> 9) & 1) << 5); R = (st >> 1) * 16 + swz / 64; C = (st & 1) * 32 + (swz % 64) / 2; }
__host__ __device__ __forceinline__ int perm32(int rho) { const int n = rho >> 4, i = rho & 15; return 8 * (i >> 2) + 4 * n + (i & 3); }

struct Unit { int pm, pn; };
struct Gemm { const bf16_t* A; const bf16_t* Bt; int lda, ldb, K; };

struct StaticOrder {
    int nM, nN, nwg, G, c;
    __device__ void init(int M, int N, int G_, int c_) { nM = M / BM; nN = N / BM; nwg = nM * nN; G = G_; c = c_; }
    __device__ bool next(int i, Unit& u) const {
        const long L = (long)i * G + c; if (L >= nwg) return false;
        int wgid = (int)L; { const int q = nwg / NXCD, r = nwg % NXCD, xcd = wgid % NXCD, off = wgid / NXCD; wgid = (xcd < r ? xcd * (q + 1) : r * (q + 1) + (xcd - r) * q) + off; }
        const int nig = WGM * nN, gid = wgid / nig, fm = gid * WGM, gsz = (nM - fm) < WGM ? (nM - fm) : WGM;
        u.pm = fm + ((wgid % nig) % gsz); u.pn = (wgid % nig) / gsz; return true;
    }
};

template <class Epi>
__device__ __forceinline__ void gemm_phase(lds_u8* lds, const Gemm g, const StaticOrder& S, const Epi& E) {
    const int tid = otid(), wid = __builtin_amdgcn_readfirstlane(tid >> 6), lane = tid & 63, wr = wid >> 2, wc = wid & 3, fr = lane & 15, fq = lane >> 4;
    const int K = g.K, nt = K / BK;
    unsigned voffA[2], voffB[2];
#pragma unroll
    for (int i = 0; i < 2; ++i) { int R, C; stage_rc(tid * 16 + i * 8192, R, C); const int Rb = Epi::PERM ? ((R & ~31) + perm32(R & 31)) : R;
        voffA[i] = (unsigned)(R * g.lda + C) * 2u; voffB[i] = (unsigned)(Rb * g.ldb + C) * 2u; }
    const size_t kstep = (size_t)(BK * 2);
    const size_t hstepA = (size_t)HALF * g.lda * 2, hstepB = (size_t)HALF * g.ldb * 2;
    const size_t tstepA = 2 * hstepA, tstepB = 2 * hstepB;
    const unsigned ldsw = (unsigned)wid * 1024u;
    const int aoff = lds_byte(wr * 64 + fr, fq * 8), boff = lds_byte(wc * 32 + fr, fq * 8);
#define PG8_SA(b, h) (((b) * 2 + (h)) * HTB)
#define PG8_SB(b, h) ((4 + (b) * 2 + (h)) * HTB)
#define PG8_STAGE(bufoff, gbase, voff) do { _Pragma("unroll") for (int _i = 0; _i < 2; ++_i) \
        __builtin_amdgcn_global_load_lds((const unsigned*)((const char*)(gbase) + (voff)[_i]), (LAS unsigned*)(lds + (bufoff) + ldsw + _i * 8192), 16, 0, 0); } while (0)
#define PG8_LDA(dst, b, h) do { _Pragma("unroll") for (int m = 0; m < 4; ++m) _Pragma("unroll") for (int k = 0; k < 2; ++k) dst[m][k] = *(const LAS bf16x8*)(lds + PG8_SA(b, h) + aoff + m * 2048 + k * 1024); } while (0)
#define PG8_LDB(dst, b, h) do { _Pragma("unroll") for (int n = 0; n < 2; ++n) _Pragma("unroll") for (int k = 0; k < 2; ++k) dst[n][k] = *(const LAS bf16x8*)(lds + PG8_SB(b, h) + boff + n * 2048 + k * 1024); } while (0)
#define PG8_MMA(ai, bj, At, Bt) do { __builtin_amdgcn_s_setprio(1); _Pragma("unroll") for (int m = 0; m < 4; ++m) _Pragma("unroll") for (int n = 0; n < 2; ++n) _Pragma("unroll") for (int k = 0; k < 2; ++k) \
        acc[ai][bj][m][n] = __builtin_amdgcn_mfma_f32_16x16x32_bf16(Bt[n][k], At[m][k], acc[ai][bj][m][n], 0, 0, 0); __builtin_amdgcn_s_setprio(0); } while (0)
#define PG8_WAIT_V(n) asm volatile("s_waitcnt vmcnt(" #n ")" ::: "memory")
#define PG8_WAIT_L(n) asm volatile("s_waitcnt lgkmcnt(" #n ")" ::: "memory")
#define PG8_BAR __builtin_amdgcn_s_barrier()
#define PG8_SCHED __builtin_amdgcn_sched_barrier(0)
    Unit cur, nxt; int ui = 0;
    if (!S.next(0, cur)) return;
    f32x4 acc[2][2][4][2];
#pragma unroll
    for (int a = 0; a < 2; ++a)
#pragma unroll
        for (int b = 0; b < 2; ++b)
#pragma unroll
            for (int m = 0; m < 4; ++m)
#pragma unroll
                for (int n = 0; n < 2; ++n) acc[a][b][m][n] = (f32x4){0.f, 0.f, 0.f, 0.f};
    bf16x8 At[4][2], B0[2][2], B1[2][2];
    const char* cA = (const char*)g.A + (size_t)cur.pm * tstepA; const char* cB = (const char*)g.Bt + (size_t)cur.pn * tstepB;
    PG8_STAGE(PG8_SB(0, 0), cB, voffB); PG8_STAGE(PG8_SB(0, 1), cB + hstepB, voffB); PG8_STAGE(PG8_SA(0, 0), cA, voffA); PG8_STAGE(PG8_SA(0, 1), cA + hstepA, voffA);
    if (wr == 1) PG8_BAR;
    PG8_WAIT_V(2); PG8_BAR;
    PG8_STAGE(PG8_SB(1, 0), cB + kstep, voffB); PG8_STAGE(PG8_SA(1, 0), cA + kstep, voffA); PG8_STAGE(PG8_SB(1, 1), cB + hstepB + kstep, voffB);
    PG8_WAIT_V(6); PG8_BAR;
    for (;;) {
        const bool has_next = S.next(ui + 1, nxt);
        const char* nA = has_next ? (const char*)g.A + (size_t)nxt.pm * tstepA : cA; const char* nB = has_next ? (const char*)g.Bt + (size_t)nxt.pn * tstepB : cB;
        for (int t = 0; t < nt; t += 2) {
            const bool last = (t == nt - 2);
            const char* a1 = cA + (size_t)(t + 1) * kstep;
            const char* a2 = last ? nA : cA + (size_t)(t + 2) * kstep; const char* b2 = last ? nB : cB + (size_t)(t + 2) * kstep;
            const char* a3 = a2 + kstep; const char* b3 = b2 + kstep;
            PG8_LDB(B0, 0, 0); PG8_LDB(B1, 0, 1); PG8_SCHED; PG8_LDA(At, 0, 0); PG8_STAGE(PG8_SA(1, 1), a1 + hstepA, voffA);
            PG8_WAIT_V(8); PG8_WAIT_L(0); PG8_BAR; PG8_MMA(0, 0, At, B0); PG8_MMA(0, 1, At, B1); PG8_BAR; PG8_SCHED;
            PG8_LDA(At, 0, 1); PG8_STAGE(PG8_SB(0, 0), b2, voffB); PG8_STAGE(PG8_SB(0, 1), b2 + hstepB, voffB); PG8_STAGE(PG8_SA(0, 0), a2, voffA);
            PG8_WAIT_V(8); PG8_WAIT_L(0); PG8_BAR; PG8_MMA(1, 0, At, B0); PG8_MMA(1, 1, At, B1); PG8_BAR; PG8_SCHED;
            PG8_LDB(B0, 1, 0); PG8_LDB(B1, 1, 1); PG8_SCHED; PG8_LDA(At, 1, 0); PG8_STAGE(PG8_SA(0, 1), a2 + hstepA, voffA);
            PG8_WAIT_V(8); PG8_WAIT_L(0); PG8_BAR; PG8_MMA(0, 0, At, B0); PG8_MMA(0, 1, At, B1); PG8_BAR; PG8_SCHED;
            PG8_LDA(At, 1, 1); PG8_STAGE(PG8_SB(1, 0), b3, voffB); PG8_STAGE(PG8_SB(1, 1), b3 + hstepB, voffB); PG8_STAGE(PG8_SA(1, 0), a3, voffA);
            PG8_WAIT_V(8); PG8_WAIT_L(0); PG8_BAR; PG8_MMA(1, 0, At, B0); PG8_MMA(1, 1, At, B1); PG8_BAR; PG8_SCHED;
        }
        if (wr == 0) PG8_BAR;
        { const int l2 = otid() & 63; E(acc, cur, wr, wc, l2 & 15, l2 >> 4); }
        if (!has_next) break;
#pragma unroll
        for (int a = 0; a < 2; ++a)
#pragma unroll
            for (int b = 0; b < 2; ++b)
#pragma unroll
                for (int m = 0; m < 4; ++m)
#pragma unroll
                    for (int n = 0; n < 2; ++n) acc[a][b][m][n] = (f32x4){0.f, 0.f, 0.f, 0.f};
        cur = nxt; cA = nA; cB = nB; ++ui;
        if (wr == 1) PG8_BAR;
    }
    PG8_WAIT_V(0);
    PG8_BAR;
#undef PG8_SA
#undef PG8_SB
#undef PG8_STAGE
#undef PG8_LDA
#undef PG8_LDB
#undef PG8_MMA
#undef PG8_WAIT_V
#undef PG8_WAIT_L
#undef PG8_BAR
#undef PG8_SCHED
}

typedef const f32x4 (&AccRef)[2][2][4][2];
DI void unit_rstd(float (&rs)[2][4], const float* ssq, int rowbase, int n4, float inv_dim, float mul) {
    const int L = otid() & 63; float own[2]; f32x4 t[2][4];
#pragma unroll
    for (int ai = 0; ai < 2; ++ai)
#pragma unroll
        for (int i = 0; i < 4; ++i) t[ai][i] = (i < n4) ? *(const f32x4*)(ssq + (size_t)(rowbase + ai * HALF + L) * 16 + 4 * i) : (f32x4){0.f, 0.f, 0.f, 0.f};
#pragma unroll
    for (int ai = 0; ai < 2; ++ai) { float s = 0.f;
#pragma unroll
        for (int i = 0; i < 4; ++i) s += (t[ai][i].x + t[ai][i].y) + (t[ai][i].z + t[ai][i].w);
        own[ai] = rsqrtf(s * inv_dim + RMS_EPS) * mul; }
#pragma unroll
    for (int ai = 0; ai < 2; ++ai)
#pragma unroll
        for (int m = 0; m < 4; ++m) rs[ai][m] = __shfl(own[ai], m * 16 + (L & 15));
}
DI void unit_rstd_s(float (&rs)[2][4], const float* ssqs, int rlbase, float mul) {
    const int L = otid() & 63; float own[2];
#pragma unroll
    for (int ai = 0; ai < 2; ++ai) { f32x4 t[8]; float s = 0.f;
#pragma unroll
        for (int i = 0; i < 8; ++i) t[i] = *(const f32x4*)(ssqs + (size_t)(rlbase + ai * HALF + L) * 32 + 4 * i);
#pragma unroll
        for (int i = 0; i < 8; ++i) s += (t[i].x + t[i].y) + (t[i].z + t[i].w);
        own[ai] = rsqrtf(s * (1.0f / DM) + RMS_EPS) * mul; asm volatile("" ::: "memory"); }
#pragma unroll
    for (int ai = 0; ai < 2; ++ai)
#pragma unroll
        for (int m = 0; m < 4; ++m) rs[ai][m] = __shfl(own[ai], m * 16 + (L & 15));
}
struct EpiSwiGLU {
    static constexpr bool PERM = true;
    bf16_t* O; const float* ssq; const float* ssqs;
    DI void operator()(AccRef acc, const Unit& u, int wr, int wc, int fr, int fq) const {
        const int row0 = u.pm * BM + wr * 64 + fr, col0 = u.pn * 128 + wc * 32 + 8 * fq;
        float rsv[2][4];
        if (u.pm * BM >= TP) unit_rstd_s(rsv, ssqs, u.pm * BM - TP + wr * 64, 1.0f); else unit_rstd(rsv, ssq, u.pm * BM + wr * 64, 4, 1.0f / DM, 1.0f);
#pragma unroll
        for (int ai = 0; ai < 2; ++ai)
#pragma unroll
            for (int m = 0; m < 4; ++m) {
                const int row = row0 + ai * HALF + m * 16; const float rs = rsv[ai][m];
                float o[8];
#pragma unroll
                for (int n = 0; n < 2; ++n)
#pragma unroll
                    for (int j = 0; j < 4; ++j) { const float gt = acc[ai][0][m][n][j] * rs, up = acc[ai][1][m][n][j] * rs;
                        const float sg = gt * __builtin_amdgcn_rcpf(1.0f + __builtin_amdgcn_exp2f(-gt * LOG2E)); o[n * 4 + j] = sg * up; }
                u32x4 w; w.x = pk2(o[0], o[1]); w.y = pk2(o[2], o[3]); w.z = pk2(o[4], o[5]); w.w = pk2(o[6], o[7]);
                *(u32x4*)(O + (size_t)row * FF + col0) = w;
            }
    }
};
struct EpiResid {
    static constexpr bool PERM = true;
    const float* Xin; float* X; bf16_t* XB; float* ssq; float scale; int row_base;
    DI void operator()(AccRef acc, const Unit& u, int wr, int wc, int fr, int fq) const {
        const int row0 = row_base + u.pm * BM + wr * 64 + fr, col0 = u.pn * BM + wc * 32 + 8 * fq;
#pragma unroll
        for (int ai = 0; ai < 2; ++ai) {
            f32x4 xo[4][2][2];
#pragma unroll
            for (int m = 0; m < 4; ++m)
#pragma unroll
                for (int bj = 0; bj < 2; ++bj)
#pragma unroll
                    for (int n = 0; n < 2; ++n) xo[m][bj][n] = *(const f32x4*)(Xin + (size_t)(row0 + ai * HALF + m * 16) * DM + col0 + bj * HALF + n * 4);
#pragma unroll
            for (int m = 0; m < 4; ++m) {
                const int row = row0 + ai * HALF + m * 16; float ss = 0.f;
#pragma unroll
                for (int bj = 0; bj < 2; ++bj) { const size_t off = (size_t)row * DM + col0 + bj * HALF;
                    const f32x4 x0 = xo[m][bj][0] + acc[ai][bj][m][0] * scale, x1 = xo[m][bj][1] + acc[ai][bj][m][1] * scale;
                    *(f32x4*)(X + off) = x0; *(f32x4*)(X + off + 4) = x1;
                    u32x4 w; w.x = pk2(x0.x, x0.y); w.y = pk2(x0.z, x0.w); w.z = pk2(x1.x, x1.y); w.w = pk2(x1.z, x1.w); *(u32x4*)(XB + off) = w;
                    ss += ((x0.x * x0.x + x0.y * x0.y) + (x0.z * x0.z + x0.w * x0.w)) + ((x1.x * x1.x + x1.y * x1.y) + (x1.z * x1.z + x1.w * x1.w)); }
                ss += __shfl_xor(ss, 16); ss += __shfl_xor(ss, 32);
                if (fq == 0) ssq[(size_t)row * 16 + u.pn * 4 + wc] = ss;
            }
            asm volatile("" ::: "memory");
        }
    }
};
struct EpiG3 {
    static constexpr bool PERM = true;
    const float* ssqx; bf16_t* CQB; float* CKV; bf16_t* LATB; float* ssqq; float* ssql; const float* ssqs;
    DI void operator()(AccRef acc, const Unit& u, int wr, int wc, int fr, int fq) const {
        const int row0 = u.pm * BM + wr * 64 + fr;
        float rsv[2][4];
        if (u.pm * BM >= TP) unit_rstd_s(rsv, ssqs, u.pm * BM - TP + wr * 64, 1.0f); else unit_rstd(rsv, ssqx, u.pm * BM + wr * 64, 4, 1.0f / DM, 1.0f);
#pragma unroll
        for (int ai = 0; ai < 2; ++ai)
#pragma unroll
            for (int m = 0; m < 4; ++m) {
                const int row = row0 + ai * HALF + m * 16; const float rs = rsv[ai][m];
#pragma unroll
                for (int bj = 0; bj < 2; ++bj) {
                    const int reg = u.pn * 2 + bj;
                    const f32x4 v0 = acc[ai][bj][m][0] * rs, v1 = acc[ai][bj][m][1] * rs;
                    const int c0 = reg * 128 + wc * 32 + 8 * fq;
                    if (reg < 5) {
                        float ss = (v0.x * v0.x + v0.y * v0.y) + (v0.z * v0.z + v0.w * v0.w) + (v1.x * v1.x + v1.y * v1.y) + (v1.z * v1.z + v1.w * v1.w);
                        ss += __shfl_xor(ss, 16); ss += __shfl_xor(ss, 32);
                        u32x4 w; w.x = pk2(v0.x, v0.y); w.y = pk2(v0.z, v0.w); w.z = pk2(v1.x, v1.y); w.w = pk2(v1.z, v1.w);
                        if (reg < 3) {
                            *(u32x4*)(CQB + (size_t)row * QL + c0) = w;
                            if (fq == 0) ssqq[(size_t)row * 16 + reg * 4 + wc] = ss;
                        } else {
                            const int lc = c0 - 384;
                            *(f32x4*)(CKV + (size_t)row * CKVW + lc) = v0; *(f32x4*)(CKV + (size_t)row * CKVW + lc + 4) = v1;
                            if (row < TP) *(u32x4*)(LATB + (size_t)row * 256 + lc) = w;
                            if (fq == 0) ssql[(size_t)row * 16 + (reg - 3) * 4 + wc] = ss;
                        }
                    } else if (wc == 0) {
                        *(f32x4*)(CKV + (size_t)row * CKVW + 256 + 8 * fq) = v0; *(f32x4*)(CKV + (size_t)row * CKVW + 256 + 8 * fq + 4) = v1;
                    }
                }
            }
    }
};
struct EpiQ {
    static constexpr bool PERM = false;
    const float* ssqq; const float* rope; bf16_t* O; int ldo, row_base, sample, mod, rem; float qscale;
    DI void operator()(AccRef acc, const Unit& u, int wr, int wc, int fr, int fq) const {
        const int row0 = u.pm * BM + wr * 64 + fr;
        float rsv[2][4]; unit_rstd(rsv, ssqq, row_base + u.pm * BM + wr * 64, 3, 1.0f / QL, qscale);
#pragma unroll
        for (int ai = 0; ai < 2; ++ai)
#pragma unroll
            for (int m = 0; m < 4; ++m) {
                const int rl = row0 + ai * HALF + m * 16; const float rs = rsv[ai][m];
                const int pos = sample ? 4096 + (rl & 15) : (rl & 4095);
#pragma unroll
                for (int bj = 0; bj < 2; ++bj) {
                    const int g32 = u.pn * 8 + bj * 4 + wc;
                    f32x4 v0 = acc[ai][bj][m][0] * rs, v1 = acc[ai][bj][m][1] * rs;
                    if (g32 % mod == rem) { const f32x4 cs = *(const f32x4*)(rope + (size_t)pos * 32 + 4 * fq), sn = *(const f32x4*)(rope + (size_t)pos * 32 + 16 + 4 * fq);
                        const f32x4 o0 = v0 * cs - v1 * sn, o1 = v0 * sn + v1 * cs; v0 = o0; v1 = o1; }
                    const size_t off = (size_t)rl * ldo + g32 * 32 + 4 * fq;
                    u32x2 w0, w1; w0.x = pk2(v0.x, v0.y); w0.y = pk2(v0.z, v0.w); w1.x = pk2(v1.x, v1.y); w1.y = pk2(v1.z, v1.w);
                    *(u32x2*)(O + off) = w0; *(u32x2*)(O + off + 16) = w1;
                }
            }
    }
};
struct EpiRowScale {
    static constexpr bool PERM = true;
    const float* ssq; int n4; float inv_dim, oscale; bf16_t* O; int ldo;
    DI void operator()(AccRef acc, const Unit& u, int wr, int wc, int fr, int fq) const {
        const int row0 = u.pm * BM + wr * 64 + fr, col0 = u.pn * BM + wc * 32 + 8 * fq;
        float rsv[2][4]; unit_rstd(rsv, ssq, u.pm * BM + wr * 64, n4, inv_dim, oscale);
#pragma unroll
        for (int ai = 0; ai < 2; ++ai)
#pragma unroll
            for (int m = 0; m < 4; ++m) {
                const int row = row0 + ai * HALF + m * 16; const float rs = rsv[ai][m];
#pragma unroll
                for (int bj = 0; bj < 2; ++bj) { const f32x4 v0 = acc[ai][bj][m][0] * rs, v1 = acc[ai][bj][m][1] * rs;
                    u32x4 w; w.x = pk2(v0.x, v0.y); w.y = pk2(v0.z, v0.w); w.z = pk2(v1.x, v1.y); w.w = pk2(v1.z, v1.w);
                    *(u32x4*)(O + (size_t)row * ldo + col0 + bj * HALF) = w; }
            }
    }
};
struct EpiKV {
    static constexpr bool PERM = true;
    const float* ssqx; bf16_t* KVSB; bf16_t* KS; float* out; const float* ssqs;
    DI void operator()(AccRef acc, const Unit& u, int wr, int wc, int fr, int fq) const {
        const int row0 = u.pm * BM + wr * 64 + fr; const bool isv = (u.pn == 1);
        float rsv[2][4];
        if (u.pm * BM >= TP) unit_rstd_s(rsv, ssqs, u.pm * BM - TP + wr * 64, 1.0f); else unit_rstd(rsv, ssqx, u.pm * BM + wr * 64, 4, 1.0f / DM, 1.0f);
#pragma unroll
        for (int ai = 0; ai < 2; ++ai)
#pragma unroll
            for (int m = 0; m < 4; ++m) {
                const int row = row0 + ai * HALF + m * 16; const float rs = rsv[ai][m];
                const bool smp = row >= TP; const int b = smp ? (row - TP) >> 4 : row >> 12, pos = smp ? (row - TP) & 15 : row & 4095;
#pragma unroll
                for (int bj = 0; bj < 2; ++bj) {
                    const f32x4 v0 = acc[ai][bj][m][0] * rs, v1 = acc[ai][bj][m][1] * rs; const int c = bj * HALF + wc * 32 + 8 * fq;
                    if (smp) { float* o = out + (isv ? O_VS : O_KS) + (size_t)(row - TP) * 256 + c; *(f32x4*)o = v0; *(f32x4*)(o + 4) = v1; }
                    else if (pos >= SEQ - 128) { float* o = out + (isv ? O_VP : O_KP) + ((size_t)b * 128 + (pos - (SEQ - 128))) * 256 + c; *(f32x4*)o = v0; *(f32x4*)(o + 4) = v1; }
                    u32x4 w; w.x = pk2(v0.x, v0.y); w.y = pk2(v0.z, v0.w); w.z = pk2(v1.x, v1.y); w.w = pk2(v1.z, v1.w);
                    if (smp) *(u32x4*)(KS + ((size_t)b * 192 + 128 + pos) * 512 + u.pn * 256 + c) = w;
                    else *(u32x4*)(KVSB + (size_t)row * 512 + u.pn * 256 + c) = w;
                }
            }
    }
};
}

typedef short v4i16_t __attribute__((ext_vector_type(4)));
DI s16x4 tr16(const lds_u8* p) { return __builtin_bit_cast(s16x4, __builtin_amdgcn_ds_read_tr16_b64_v4i16((LAS v4i16_t*)p)); }

template <int DQK, int DROW, int KSPLIT, int KGAP, int VOFF, int NDB, int NBLK, bool BIAS>
DI void flash_unit(lds_u8* lds, const bf16_t* qrow, const bf16_t* kA, int pitchA, int da8, const bf16_t* kB, int pitchB,
                   int dofs, int j0, int ntiles, int my_tiles, int kvlimit,
                   float m_init, float l_init, const LAS float* bias_tab, int bias_off, bf16_t* orow, bool store_ok) {
    constexpr int CPR = DROW / 8, ROWB = DROW * 2 + 16, TILEB = 64 * ROWB;
    constexpr int NCH = 64 * CPR, NKR = (NCH + 511) / 512, ND0 = DQK / 16;
    const int tid = otid(), lane = tid & 63, r = lane & 31, h = lane >> 5;
    bf16x8 qf[ND0];
#pragma unroll
    for (int d0 = 0; d0 < ND0; ++d0) qf[d0] = *(const bf16x8*)(qrow + 16 * d0 + 8 * h);
    f32x16 O[NDB];
#pragma unroll
    for (int d = 0; d < NDB; ++d)
#pragma unroll
        for (int i = 0; i < 16; ++i) O[d][i] = 0.f;
    float mrun = m_init, lrun = l_init;
    u32x4 kreg[3][NKR];
    const u32x4 zero4 = {0u, 0u, 0u, 0u};
#define FL_LOAD(st, jt) do { const int kv0_ = (jt) * 64; \
    _Pragma("unroll") for (int i_ = 0; i_ < NKR; ++i_) { const int c_ = tid + i_ * 512; if ((NCH % 512 == 0) || c_ < NCH) { const int row_ = c_ / CPR, cc_ = c_ % CPR, kv_ = kv0_ + row_; \
        const bf16_t* s_ = (cc_ < da8) ? kA + (size_t)kv_ * pitchA + cc_ * 8 : kB + (size_t)kv_ * pitchB + (cc_ - da8) * 8; \
        kreg[st][i_] = (kv_ < kvlimit) ? *(const u32x4*)s_ : zero4; } } } while (0)
#define FL_STORE(st, buf) do { \
    _Pragma("unroll") for (int i_ = 0; i_ < NKR; ++i_) { const int c_ = tid + i_ * 512; if ((NCH % 512 == 0) || c_ < NCH) { const int row_ = c_ / CPR, cc_ = c_ % CPR; \
        *(LAS u32x4*)(lds + (buf) * TILEB + row_ * ROWB + cc_ * 16) = kreg[st][i_]; } } } while (0)
    const int nt = ntiles - j0;
    FL_LOAD(0, j0); if (nt > 1) FL_LOAD(1, j0 + 1); if (nt > 2) FL_LOAD(2, j0 + 2);
    FL_STORE(0, 0); if (nt > 3) FL_LOAD(0, j0 + 3); __syncthreads();
    const int vlane = (4 * h + ((lane & 15) >> 2)) * ROWB + (VOFF + dofs + 16 * ((lane >> 4) & 1) + 4 * (lane & 3)) * 2;
    for (int t0 = 0; t0 < nt; t0 += 3) {
#pragma unroll
      for (int s3 = 0; s3 < 3; ++s3) {
        const int t = t0 + s3;
        if (t < nt) {
        const int j = j0 + t, buf = t & 1;
        if (j < my_tiles) {
            const lds_u8* Kt = lds + buf * TILEB;
#pragma unroll
            for (int ss = 0; ss < 2; ss += NBLK) {
                f32x16 S[NBLK];
#pragma unroll
                for (int b = 0; b < NBLK; ++b) {
#pragma unroll
                    for (int i = 0; i < 16; ++i) S[b][i] = 0.f;
                    const lds_u8* kp = Kt + ((ss + b) * 32 + r) * ROWB + h * 16;
#pragma unroll
                    for (int d0 = 0; d0 < ND0; ++d0) { const bf16x8 kf = *(const LAS bf16x8*)(kp + (16 * d0 + (d0 >= KSPLIT ? KGAP : 0)) * 2); S[b] = MFMA32(kf, qf[d0], S[b]); }
                }
                if (BIAS) {
#pragma unroll
                    for (int b = 0; b < NBLK; ++b)
#pragma unroll
                        for (int i = 0; i < 16; ++i) S[b][i] += bias_tab[j * 64 + (ss + b) * 32 + crow(i, h) + bias_off];
                }
                if (j * 64 + 64 > kvlimit) {
#pragma unroll
                    for (int b = 0; b < NBLK; ++b)
#pragma unroll
                        for (int i = 0; i < 16; ++i) if (j * 64 + (ss + b) * 32 + crow(i, h) >= kvlimit) S[b][i] = -1e30f;
                }
                float mt = S[0][0];
#pragma unroll
                for (int b = 0; b < NBLK; ++b)
#pragma unroll
                    for (int i = 0; i < 16; ++i) mt = fmaxf(mt, S[b][i]);
                mt = halfmax(mt);
                if (__any(mt > mrun)) {
                    const float mn0 = fmaxf(mrun, mt); const float alpha = __builtin_amdgcn_exp2f(mrun - mn0); mrun = mn0; lrun *= alpha;
#pragma unroll
                    for (int d = 0; d < NDB; ++d)
#pragma unroll
                        for (int i = 0; i < 16; ++i) O[d][i] *= alpha;
                }
                const float mn = mrun;
                float ps = 0.f;
#pragma unroll
                for (int b = 0; b < NBLK; ++b)
#pragma unroll
                    for (int i = 0; i < 16; ++i) { const float pe = __builtin_amdgcn_exp2f(S[b][i] - mn); S[b][i] = pe; ps += pe; }
                lrun += ps;
                bf16x8 pk[NBLK][2];
#pragma unroll
                for (int b = 0; b < NBLK; ++b)
#pragma unroll
                    for (int s = 0; s < 2; ++s) { u32x4 w; w.x = pk2(S[b][8 * s], S[b][8 * s + 1]); w.y = pk2(S[b][8 * s + 2], S[b][8 * s + 3]); w.z = pk2(S[b][8 * s + 4], S[b][8 * s + 5]); w.w = pk2(S[b][8 * s + 6], S[b][8 * s + 7]);
                        pk[b][s] = __builtin_bit_cast(bf16x8, w); }
                const lds_u8* vp = Kt + vlane;
#pragma unroll
                for (int d = 0; d < NDB; ++d) {
#pragma unroll
                    for (int b = 0; b < NBLK; ++b)
#pragma unroll
                        for (int s = 0; s < 2; ++s) { const int off = ((ss + b) * 32 + 16 * s) * ROWB + d * 64;
                            const s16x4 lo = tr16(vp + off), hi = tr16(vp + off + 8 * ROWB);
                            const bf16x8 vf = __builtin_shufflevector(lo, hi, 0, 1, 2, 3, 4, 5, 6, 7);
                            O[d] = MFMA32(vf, pk[b][s], O[d]); }
                }
            }
        }
        if (t + 1 < nt) FL_STORE((s3 + 1) % 3, buf ^ 1);
        if (t + 4 < nt) FL_LOAD((s3 + 1) % 3, j + 4);
        __syncthreads();
        }
      }
    }
#undef FL_LOAD
#undef FL_STORE
    const float lt = lrun + __shfl_xor(lrun, 32); const float inv = 1.0f / lt;
    if (store_ok) {
#pragma unroll
        for (int d = 0; d < NDB; ++d)
#pragma unroll
            for (int g = 0; g < 4; ++g) { u32x2 w; w.x = pk2(O[d][4 * g] * inv, O[d][4 * g + 1] * inv); w.y = pk2(O[d][4 * g + 2] * inv, O[d][4 * g + 3] * inv);
                *(u32x2*)(orow + dofs + d * 32 + 8 * g + 4 * h) = w; }
    }
}


DI void flash_abs_unit(lds_u8* lds, const bf16_t* qrow, const float* latA, const float* ropeA, const float* latN, const float* ropeN, int dofs, bf16_t* orow) {
    constexpr int ROWB = 592, TR = 32, TILEB = TR * ROWB, ND0 = 18, NDB = 4, NT = 129, KVLIM = 4112;
    const int tid = otid(), lane = tid & 63, r = lane & 31, h = lane >> 5;
    bf16x8 qf[ND0];
#pragma unroll
    for (int d0 = 0; d0 < ND0; ++d0) qf[d0] = *(const bf16x8*)(qrow + 16 * d0 + 8 * h);
    f32x16 O[NDB];
#pragma unroll
    for (int d = 0; d < NDB; ++d)
#pragma unroll
        for (int i = 0; i < 16; ++i) O[d][i] = 0.f;
    float mrun = -1e30f, lrun = 0.f;
    f32x4 kf[2][2][2], kr[2];
#define FA_LOAD(st, jt) do { const int kv0_ = (jt) * TR; \
    _Pragma("unroll") for (int i_ = 0; i_ < 2; ++i_) { const int c_ = tid + i_ * 512; const int row_ = c_ >> 5, cc_ = c_ & 31; int kv_ = kv0_ + row_; kv_ = kv_ < KVLIM ? kv_ : KVLIM - 1;   \
        const float* s_ = (kv_ < 4096 ? latA + (size_t)kv_ * 256 : latN + (size_t)(kv_ - 4096) * 256) + cc_ * 8; \
        kf[st][i_][0] = *(const f32x4*)s_; kf[st][i_][1] = *(const f32x4*)(s_ + 4); } \
    if (tid < 256) { const int row_ = tid >> 3, qq_ = tid & 7; int kv_ = kv0_ + row_; kv_ = kv_ < KVLIM ? kv_ : KVLIM - 1; \
        kr[st] = *(const f32x4*)((kv_ < 4096 ? ropeA + (size_t)kv_ * 32 : ropeN + (size_t)(kv_ - 4096) * 32) + qq_ * 4); } } while (0)
#define FA_STORE(st, buf) do { \
    _Pragma("unroll") for (int i_ = 0; i_ < 2; ++i_) { const int c_ = tid + i_ * 512; const int row_ = c_ >> 5, cc_ = c_ & 31; \
        u32x4 w_; w_.x = pk2(kf[st][i_][0].x, kf[st][i_][0].y); w_.y = pk2(kf[st][i_][0].z, kf[st][i_][0].w); w_.z = pk2(kf[st][i_][1].x, kf[st][i_][1].y); w_.w = pk2(kf[st][i_][1].z, kf[st][i_][1].w); \
        *(LAS u32x4*)(lds + (buf) * TILEB + row_ * ROWB + cc_ * 16) = w_; } \
    if (tid < 256) { const int row_ = tid >> 3, qq_ = tid & 7; u32x2 w2_; w2_.x = pk2(kr[st].x, kr[st].y); w2_.y = pk2(kr[st].z, kr[st].w); \
        *(LAS u32x2*)(lds + (buf) * TILEB + row_ * ROWB + 512 + qq_ * 8) = w2_; } } while (0)
#define FA_COMPUTE(j, buf) do { \
            const lds_u8* Kt = lds + (buf) * TILEB; \
            f32x16 S; \
            _Pragma("unroll") for (int i = 0; i < 16; ++i) S[i] = 0.f; \
            const lds_u8* kp = Kt + r * ROWB + h * 16; \
            _Pragma("unroll") for (int d0 = 0; d0 < ND0; ++d0) { const bf16x8 kfr = *(const LAS bf16x8*)(kp + d0 * 32); S = MFMA32(kfr, qf[d0], S); } \
            if ((j) * TR + TR > KVLIM) { \
                _Pragma("unroll") for (int i = 0; i < 16; ++i) if ((j) * TR + crow(i, h) >= KVLIM) S[i] = -1e30f; \
            } \
            float mt = S[0]; \
            _Pragma("unroll") for (int i = 1; i < 16; ++i) mt = fmaxf(mt, S[i]); \
            mt = halfmax(mt); \
            if (__any(mt > mrun)) { const float mn0 = fmaxf(mrun, mt); const float alpha = __builtin_amdgcn_exp2f(mrun - mn0); mrun = mn0; lrun *= alpha; \
                _Pragma("unroll") for (int d = 0; d < NDB; ++d) _Pragma("unroll") for (int i = 0; i < 16; ++i) O[d][i] *= alpha; } \
            const float mn = mrun; \
            float ps = 0.f; \
            _Pragma("unroll") for (int i = 0; i < 16; ++i) { const float pe = __builtin_amdgcn_exp2f(S[i] - mn); S[i] = pe; ps += pe; } \
            lrun += ps; \
            bf16x8 pk[2]; \
            _Pragma("unroll") for (int s = 0; s < 2; ++s) { u32x4 w; w.x = pk2(S[8 * s], S[8 * s + 1]); w.y = pk2(S[8 * s + 2], S[8 * s + 3]); w.z = pk2(S[8 * s + 4], S[8 * s + 5]); w.w = pk2(S[8 * s + 6], S[8 * s + 7]); \
                pk[s] = __builtin_bit_cast(bf16x8, w); } \
            const lds_u8* vp = Kt + vlane; \
            _Pragma("unroll") for (int d = 0; d < NDB; ++d) _Pragma("unroll") for (int s = 0; s < 2; ++s) { const int off = (16 * s) * ROWB + d * 64; \
                    const s16x4 lo = tr16(vp + off), hi = tr16(vp + off + 8 * ROWB); \
                    const bf16x8 vf = __builtin_shufflevector(lo, hi, 0, 1, 2, 3, 4, 5, 6, 7); \
                    O[d] = MFMA32(vf, pk[s], O[d]); } } while (0)
    const int vlane = (4 * h + ((lane & 15) >> 2)) * ROWB + (dofs + 16 * ((lane >> 4) & 1) + 4 * (lane & 3)) * 2;
    FA_LOAD(0, 0); FA_LOAD(1, 1); FA_STORE(0, 0); FA_LOAD(0, 2); __syncthreads();
    for (int j0 = 0; j0 < NT; j0 += 2) {
        { const int j = j0; FA_COMPUTE(j, 0); if (j + 1 < NT) FA_STORE(1, 1); if (j + 3 < NT) FA_LOAD(1, j + 3); __syncthreads(); }
        if (j0 + 1 < NT) { const int j = j0 + 1; FA_COMPUTE(j, 1); if (j + 1 < NT) FA_STORE(0, 0); if (j + 3 < NT) FA_LOAD(0, j + 3); __syncthreads(); }
    }
#undef FA_COMPUTE
#undef FA_LOAD
#undef FA_STORE
    const float lt = lrun + __shfl_xor(lrun, 32); const float inv = 1.0f / lt;
#pragma unroll
    for (int d = 0; d < NDB; ++d)
#pragma unroll
        for (int g = 0; g < 4; ++g) { u32x2 w; w.x = pk2(O[d][4 * g] * inv, O[d][4 * g + 1] * inv); w.y = pk2(O[d][4 * g + 2] * inv, O[d][4 * g + 3] * inv);
            *(u32x2*)(orow + dofs + d * 32 + 8 * g + 4 * h) = w; }
}

template <class Epi>
DI void sgemm_phase(lds_u8* lds, const bf16_t* A, int lda, const bf16_t* Bt, int ldb, int K, int nN, int G, int bid, const Epi& E) {
    constexpr int PB = 144, TA = 64 * PB, TB = TA + 256 * PB;
    const int tid = otid(), lane = tid & 63, wave = __builtin_amdgcn_readfirstlane(tid >> 6), r = lane & 31, h = lane >> 5, wm = wave >> 2, wn = wave & 3;
    const int ntiles = 8 * nN, nk = K / 64;
    for (int t = G - 1 - bid; t < ntiles; t += G) {
        const int mi = t & 7, ni = t >> 3;
        const bf16_t* Ap = A + (size_t)(mi * 64 + (tid >> 3)) * lda + (tid & 7) * 8;
        const bf16_t* Bp = Bt + (size_t)(ni * 256 + (tid >> 3)) * ldb + (tid & 7) * 8;
        f32x16 acc0, acc1;
#pragma unroll
        for (int i = 0; i < 16; ++i) { acc0[i] = 0.f; acc1[i] = 0.f; }
        u32x4 ra[4], rb[4][4];
#define SG_LOAD(s, kt) do { ra[s] = *(const u32x4*)(Ap + (kt) * 64); _Pragma("unroll") for (int i_ = 0; i_ < 4; ++i_) rb[s][i_] = *(const u32x4*)(Bp + (size_t)i_ * 64 * ldb + (kt) * 64); } while (0)
#define SG_STORE(s, buf) do { lds_u8* b_ = lds + (buf) * TB + (tid >> 3) * PB + (tid & 7) * 16; *(LAS u32x4*)b_ = ra[s]; \
        _Pragma("unroll") for (int i_ = 0; i_ < 4; ++i_) *(LAS u32x4*)(b_ + TA + i_ * 64 * PB) = rb[s][i_]; } while (0)
#pragma unroll
        for (int s = 0; s < 4; ++s) if (s < nk) SG_LOAD(s, s);
        for (int kt0 = 0; kt0 < nk; kt0 += 4) {
#pragma unroll
            for (int s = 0; s < 4; ++s) {
                const int kt = kt0 + s;
                if (kt < nk) {
                    const int buf = s & 1;
                    SG_STORE(s, buf);
                    if (kt + 4 < nk) SG_LOAD(s, kt + 4);
                    __syncthreads();
                    const lds_u8* Aa = lds + buf * TB + (32 * wm + r) * PB + h * 16;
                    const lds_u8* Bb = lds + buf * TB + TA + (32 * wn + r) * PB + h * 16;
#pragma unroll
                    for (int ks = 0; ks < 4; ++ks) {
                        const bf16x8 af = *(const LAS bf16x8*)(Aa + ks * 32), w0 = *(const LAS bf16x8*)(Bb + ks * 32), w1 = *(const LAS bf16x8*)(Bb + 128 * PB + ks * 32);
                        acc0 = MFMA32(w0, af, acc0); acc1 = MFMA32(w1, af, acc1);
                    }
                }
            }
        }
        __syncthreads();
#undef SG_LOAD
#undef SG_STORE
        E(acc0, acc1, mi * 64 + 32 * wm + r, ni, wn, h);
    }
}
DI float silu_mul(float gt, float up) { return gt * __builtin_amdgcn_rcpf(1.0f + __builtin_amdgcn_exp2f(-gt * LOG2E)) * up; }
struct SEpiSwiGLU {
    bf16_t* O; const float* ssq;
    DI void operator()(const f32x16& a0, const f32x16& a1, int rl, int ni, int wn, int h) const {
        const int row = TP + rl; const float rs = srow_rstd(ssq, rl);
        bf16_t* o = O + (size_t)row * FF + ni * 128 + 32 * wn + 4 * h;
#pragma unroll
        for (int g = 0; g < 4; ++g) { u32x2 w; w.x = pk2(silu_mul(a0[4 * g] * rs, a1[4 * g] * rs), silu_mul(a0[4 * g + 1] * rs, a1[4 * g + 1] * rs));
            w.y = pk2(silu_mul(a0[4 * g + 2] * rs, a1[4 * g + 2] * rs), silu_mul(a0[4 * g + 3] * rs, a1[4 * g + 3] * rs)); *(u32x2*)(o + 8 * g) = w; }
    }
};
struct SEpiResid {
    const float* Xin; float* X; bf16_t* XB; float* ssqs; float scale;
    DI void operator()(const f32x16& a0, int rl, int ni, int wn, int h) const {
        const int row = TP + rl; float ss = 0.f;
        f32x4 xov[4];
#pragma unroll
        for (int g = 0; g < 4; ++g) xov[g] = *(const f32x4*)(Xin + (size_t)row * DM + ni * 128 + 32 * wn + 4 * h + 8 * g);
#pragma unroll
        for (int g = 0; g < 4; ++g) { const size_t off = (size_t)row * DM + ni * 128 + 32 * wn + 4 * h + 8 * g;
            const f32x4 av = (f32x4){a0[4 * g], a0[4 * g + 1], a0[4 * g + 2], a0[4 * g + 3]};
            const f32x4 xo = xov[g]; const f32x4 xn = xo + av * scale; *(f32x4*)(X + off) = xn;
            u32x2 w; w.x = pk2(xn.x, xn.y); w.y = pk2(xn.z, xn.w); *(u32x2*)(XB + off) = w; ss += (xn.x * xn.x + xn.y * xn.y) + (xn.z * xn.z + xn.w * xn.w); }
        ss += __shfl_xor(ss, 32);
        if (h == 0) ssqs[(size_t)rl * 32 + ni * 4 + wn] = ss;
    }
};
struct SEpiG3 {
    const float* ssqx; bf16_t* CQB; float* CKV; float* ssqq;
    DI void operator()(const f32x16& a0, const f32x16& a1, int rl, int ni, int wn, int h) const {
        const int row = TP + rl; const float rs = srow_rstd(ssqx, rl);
#pragma unroll
        for (int blk = 0; blk < 2; ++blk) {
            const int reg = ni * 2 + blk; const int c0 = reg * 128 + 32 * wn + 4 * h;
            f32x4 v[4]; float ss = 0.f;
#pragma unroll
            for (int g = 0; g < 4; ++g) { v[g] = (blk ? (f32x4){a1[4 * g], a1[4 * g + 1], a1[4 * g + 2], a1[4 * g + 3]} : (f32x4){a0[4 * g], a0[4 * g + 1], a0[4 * g + 2], a0[4 * g + 3]}) * rs;
                ss += (v[g].x * v[g].x + v[g].y * v[g].y) + (v[g].z * v[g].z + v[g].w * v[g].w); }
            if (reg < 3) {
                ss += __shfl_xor(ss, 32);
#pragma unroll
                for (int g = 0; g < 4; ++g) { u32x2 w; w.x = pk2(v[g].x, v[g].y); w.y = pk2(v[g].z, v[g].w); *(u32x2*)(CQB + (size_t)row * QL + c0 + 8 * g) = w; }
                if (h == 0) ssqq[(size_t)row * 16 + reg * 4 + wn] = ss;
            } else if (reg < 5) {
#pragma unroll
                for (int g = 0; g < 4; ++g) *(f32x4*)(CKV + (size_t)row * CKVW + (c0 - 384) + 8 * g) = v[g];
            } else if (wn == 0) {
#pragma unroll
                for (int g = 0; g < 4; ++g) *(f32x4*)(CKV + (size_t)row * CKVW + 256 + 4 * h + 8 * g) = v[g];
            }
        }
    }
};
struct SEpiQabs {
    const float* ssqq; const float* rope; bf16_t* O; float qscale;
    DI void operator()(const f32x16& a0, const f32x16& a1, int rl, int ni, int wn, int h) const {
        const float rs = row_rstd(ssqq, TP + rl, 3, 1.0f / QL) * qscale; const int pos = 4096 + (rl & 15);
#pragma unroll
        for (int blk = 0; blk < 2; ++blk) {
            const int g32 = ni * 8 + blk * 4 + wn; float v[16];
#pragma unroll
            for (int i = 0; i < 16; ++i) v[i] = (blk ? a1[i] : a0[i]) * rs;
            if (g32 % 9 == 8) {
#pragma unroll
                for (int i = 0; i < 8; ++i) { const int f = crow(i, h); const float cs = rope[(size_t)pos * 32 + f], sn = rope[(size_t)pos * 32 + 16 + f];
                    const float x1 = v[i], x2 = v[i + 8]; v[i] = x1 * cs - x2 * sn; v[i + 8] = x1 * sn + x2 * cs; }
            }
            bf16_t* o = O + (size_t)rl * 4608 + g32 * 32 + 4 * h;
#pragma unroll
            for (int g = 0; g < 4; ++g) { u32x2 w; w.x = pk2(v[4 * g], v[4 * g + 1]); w.y = pk2(v[4 * g + 2], v[4 * g + 3]); *(u32x2*)(o + 8 * g) = w; }
        }
    }
};
struct SEpiKV {
    const float* ssqx; bf16_t* KS; float* out;
    DI void operator()(const f32x16& a0, const f32x16& a1, int rl, int ni, int wn, int h) const {
        const float rs = srow_rstd(ssqx, rl); const int b = rl >> 4, s = rl & 15;
#pragma unroll
        for (int blk = 0; blk < 2; ++blk)
#pragma unroll
            for (int g = 0; g < 4; ++g) { const int c = blk * 128 + 32 * wn + 4 * h + 8 * g;
                const f32x4 v = (blk ? (f32x4){a1[4 * g], a1[4 * g + 1], a1[4 * g + 2], a1[4 * g + 3]} : (f32x4){a0[4 * g], a0[4 * g + 1], a0[4 * g + 2], a0[4 * g + 3]}) * rs;
                *(f32x4*)(out + (ni ? O_VS : O_KS) + (size_t)rl * 256 + c) = v;
                u32x2 w; w.x = pk2(v.x, v.y); w.y = pk2(v.z, v.w); *(u32x2*)(KS + ((size_t)b * 192 + 128 + s) * 512 + ni * 256 + c) = w; }
    }
};
struct SEpiRowScale {
    const float* ssqs; float oscale; bf16_t* O;
    DI void operator()(const f32x16& a0, int rl, int ni, int wn, int h) const {
        const int row = TP + rl; const float rs = srow_rstd(ssqs, rl) * oscale;
#pragma unroll
        for (int g = 0; g < 4; ++g) { u32x2 w; const int i = 4 * g; w.x = pk2(a0[i] * rs, a0[i + 1] * rs); w.y = pk2(a0[i + 2] * rs, a0[i + 3] * rs);
            *(u32x2*)(O + (size_t)row * DM + ni * 128 + 32 * wn + 4 * h + 8 * g) = w; }
    }
};
template <class Epi>
DI void sgemm64_phase(lds_u8* lds, const bf16_t* A, int lda, const bf16_t* Bt, int ldb, int K, int nN64, int G, int bid, const Epi& E) {
    constexpr int BKS = 256, PB = BKS * 2 + 16, TA = 32 * PB, TB = TA + 64 * PB, RED = 2 * TB;
    static_assert(RED + 32768 <= LDS_SLOT, "LDS");
    const int tid = otid(), lane = tid & 63, wave = __builtin_amdgcn_readfirstlane(tid >> 6), r = lane & 31, h = lane >> 5, cb = wave & 1, ks = wave >> 1;
    const int ntiles = 16 * nN64, nk = K / BKS;
    for (int t = G - 1 - bid; t < ntiles; t += G) {
        const int mi = t & 15, ni = t >> 4;
        const bf16_t* Ap = A + (size_t)(mi * 32 + (tid >> 5)) * lda + (tid & 31) * 8;
        const bf16_t* Bp = Bt + (size_t)(ni * 64 + (tid >> 5)) * ldb + (tid & 31) * 8;
        f32x16 acc;
#pragma unroll
        for (int i = 0; i < 16; ++i) acc[i] = 0.f;
        u32x4 ra[4][2], rb[4][4];
#define SG_LOAD(s, kt) do { _Pragma("unroll") for (int i_ = 0; i_ < 2; ++i_) ra[s][i_] = *(const u32x4*)(Ap + (size_t)i_ * 16 * lda + (kt) * BKS); \
        _Pragma("unroll") for (int i_ = 0; i_ < 4; ++i_) rb[s][i_] = *(const u32x4*)(Bp + (size_t)i_ * 16 * ldb + (kt) * BKS); } while (0)
#define SG_STORE(s, buf) do { lds_u8* b_ = lds + (buf) * TB + (tid >> 5) * PB + (tid & 31) * 16; \
        _Pragma("unroll") for (int i_ = 0; i_ < 2; ++i_) *(LAS u32x4*)(b_ + i_ * 16 * PB) = ra[s][i_]; \
        _Pragma("unroll") for (int i_ = 0; i_ < 4; ++i_) *(LAS u32x4*)(b_ + TA + i_ * 16 * PB) = rb[s][i_]; } while (0)
#pragma unroll
        for (int s = 0; s < 4; ++s) if (s < nk) SG_LOAD(s, s);
        for (int kt0 = 0; kt0 < nk; kt0 += 4) {
#pragma unroll
            for (int s = 0; s < 4; ++s) {
                const int kt = kt0 + s;
                if (kt < nk) {
                    const int buf = s & 1;
                    SG_STORE(s, buf);
                    if (kt + 4 < nk) SG_LOAD(s, kt + 4);
                    __syncthreads();
                    const lds_u8* Aa = lds + buf * TB + r * PB + ks * 128 + h * 16;
                    const lds_u8* Bb = lds + buf * TB + TA + (32 * cb + r) * PB + ks * 128 + h * 16;
#pragma unroll
                    for (int j = 0; j < 4; ++j) { const bf16x8 af = *(const LAS bf16x8*)(Aa + j * 32), w0 = *(const LAS bf16x8*)(Bb + j * 32); acc = MFMA32(w0, af, acc); }
                }
            }
        }
        __syncthreads();
#undef SG_LOAD
#undef SG_STORE
        LAS f32x4* red = (LAS f32x4*)(lds + RED) + ((cb * 4 + ks) * 64 + lane) * 4;
        if (ks != 0) {
#pragma unroll
            for (int q = 0; q < 4; ++q) red[q] = (f32x4){acc[4 * q], acc[4 * q + 1], acc[4 * q + 2], acc[4 * q + 3]};
        }
        __syncthreads();
        if (ks == 0) {
#pragma unroll
            for (int o = 1; o < 4; ++o)
#pragma unroll
                for (int q = 0; q < 4; ++q) { const f32x4 v = red[o * 64 * 4 + q]; acc[4 * q] += v.x; acc[4 * q + 1] += v.y; acc[4 * q + 2] += v.z; acc[4 * q + 3] += v.w; }
            E(acc, mi * 32 + r, ni >> 1, (ni & 1) * 2 + cb, h);
        }
        __syncthreads();
    }
}
template <class Epi>
DI void sgemm128_phase(lds_u8* lds, const bf16_t* A, int lda, const bf16_t* Bt, int ldb, int K, int nN  , int G, int bid, const Epi& E) {
    constexpr int PB = 144, TA = 64 * PB, TB = TA + 128 * PB;
    const int tid = otid(), lane = tid & 63, wave = __builtin_amdgcn_readfirstlane(tid >> 6), r = lane & 31, h = lane >> 5, wm = wave >> 2, wn = wave & 3;
    const int ntiles = 8 * nN, nk = K / 64;
    for (int t = G - 1 - bid; t < ntiles; t += G) {
        const int mi = t & 7, ni = t >> 3;
        const bf16_t* Ap = A + (size_t)(mi * 64 + (tid >> 3)) * lda + (tid & 7) * 8;
        const bf16_t* Bp = Bt + (size_t)(ni * 128 + (tid >> 3)) * ldb + (tid & 7) * 8;
        f32x16 acc0;
#pragma unroll
        for (int i = 0; i < 16; ++i) acc0[i] = 0.f;
        u32x4 ra[4], rb[4][2];
#define SG_LOAD(s, kt) do { ra[s] = *(const u32x4*)(Ap + (kt) * 64); _Pragma("unroll") for (int i_ = 0; i_ < 2; ++i_) rb[s][i_] = *(const u32x4*)(Bp + (size_t)i_ * 64 * ldb + (kt) * 64); } while (0)
#define SG_STORE(s, buf) do { lds_u8* b_ = lds + (buf) * TB + (tid >> 3) * PB + (tid & 7) * 16; *(LAS u32x4*)b_ = ra[s]; \
        _Pragma("unroll") for (int i_ = 0; i_ < 2; ++i_) *(LAS u32x4*)(b_ + TA + i_ * 64 * PB) = rb[s][i_]; } while (0)
#pragma unroll
        for (int s = 0; s < 4; ++s) if (s < nk) SG_LOAD(s, s);
        for (int kt0 = 0; kt0 < nk; kt0 += 4) {
#pragma unroll
            for (int s = 0; s < 4; ++s) {
                const int kt = kt0 + s;
                if (kt < nk) {
                    const int buf = s & 1;
                    SG_STORE(s, buf);
                    if (kt + 4 < nk) SG_LOAD(s, kt + 4);
                    __syncthreads();
                    const lds_u8* Aa = lds + buf * TB + (32 * wm + r) * PB + h * 16;
                    const lds_u8* Bb = lds + buf * TB + TA + (32 * wn + r) * PB + h * 16;
#pragma unroll
                    for (int ks = 0; ks < 4; ++ks) {
                        const bf16x8 af = *(const LAS bf16x8*)(Aa + ks * 32), w0 = *(const LAS bf16x8*)(Bb + ks * 32);
                        acc0 = MFMA32(w0, af, acc0);
                    }
                }
            }
        }
        __syncthreads();
#undef SG_LOAD
#undef SG_STORE
        E(acc0, mi * 64 + 32 * wm + r, ni, wn, h);
    }
}

DI void tr_item(const float* W, int ldw, const float* gain, bf16_t* WT, int ldo, int mode, int row_off, LAS float* scr, int kb, int nb, int lane) {
    const int k0 = 64 * kb, n0 = 32 * nb;
#pragma unroll 16
    for (int i = 0; i < 32; ++i) { const int kk = 2 * i + (lane >> 5); float v = W[(size_t)(k0 + kk) * ldw + n0 + (lane & 31)]; if (gain) v *= gain[k0 + kk]; scr[kk * 33 + (lane & 31)] = v; }
    asm volatile("s_waitcnt lgkmcnt(0)" ::: "memory");
    const int c = lane & 7;
#pragma unroll
    for (int j = 0; j < 4; ++j) { const int n = (lane >> 3) + 8 * j; const LAS float* s = scr + (8 * c) * 33 + n;
        u32x4 o; o.x = pk2(s[0 * 33], s[1 * 33]); o.y = pk2(s[2 * 33], s[3 * 33]); o.z = pk2(s[4 * 33], s[5 * 33]); o.w = pk2(s[6 * 33], s[7 * 33]);
        const int nn = n0 + n; const int orow = (mode == 0) ? row_off + nn : (mode <= 2) ? ((nn >> 7) * 256 + (nn & 127) + (mode == 2 ? 128 : 0)) : ((nn >> 6) * 128 + (nn & 63) + (mode == 4 ? 64 : 0));
        *(u32x4*)(WT + (size_t)orow * ldo + k0 + 8 * c) = o; }
    asm volatile("s_waitcnt lgkmcnt(0)" ::: "memory");
}
DI void tr64_item(const float* W, int ldw, const float* gain, bf16_t* WT, int ldo, int mode, LAS float* scr, int kb, int nb, int lane) {
    const int k0 = 64 * kb, n0 = 64 * nb;
    float v[64];
    const float* src = W + (size_t)k0 * ldw + n0 + lane;
#pragma unroll
    for (int i = 0; i < 64; ++i) v[i] = src[(size_t)i * ldw];
    if (gain) {
#pragma unroll
        for (int i = 0; i < 64; ++i) v[i] *= gain[k0 + i];
    }
#pragma unroll
    for (int i = 0; i < 64; ++i) scr[i * 65 + lane] = v[i];
    asm volatile("s_waitcnt lgkmcnt(0)" ::: "memory");
    const int c = lane & 7;
#pragma unroll
    for (int j = 0; j < 8; ++j) { const int n = (lane >> 3) + 8 * j; const LAS float* s = scr + (8 * c) * 65 + n;
        u32x4 o; o.x = pk2(s[0 * 65], s[1 * 65]); o.y = pk2(s[2 * 65], s[3 * 65]); o.z = pk2(s[4 * 65], s[5 * 65]); o.w = pk2(s[6 * 65], s[7 * 65]);
        const int nn = n0 + n; const int orow = (mode == 0) ? nn : (mode <= 2) ? ((nn >> 7) * 256 + (nn & 127) + (mode == 2 ? 128 : 0)) : ((nn >> 6) * 128 + (nn & 63) + (mode == 4 ? 64 : 0));
        *(u32x4*)(WT + (size_t)orow * ldo + k0 + 8 * c) = o; }
    asm volatile("s_waitcnt lgkmcnt(0)" ::: "memory");
}
DI void tr_matrix(const float* W, int K, int N, const float* gain, bf16_t* WT, int ldo, int mode, int row_off, LAS float* scr, int gw, int NGW, int lane) {
    const int nblk = N / 32, nitems = (K / 64) * nblk;
    for (int it = gw; it < nitems; it += NGW) tr_item(W, N, gain, WT, ldo, mode, row_off, scr, it / nblk, it % nblk, lane);
}


#define XB_TMO      128
#define XB_XCNT(j)  (256  + 64 * (j))
#define XB_XSUB(j)  (1280 + 64 * (j))
#define XB_XGEN(j)  (2304 + 64 * (j))
#define XB_TOP      3328
#define XB_TOPGEN   3392
#define XB_SPIN_CAP (1u << 22)
DI unsigned xb_ld(unsigned* p)              { return __hip_atomic_load(p, __ATOMIC_RELAXED, __HIP_MEMORY_SCOPE_AGENT); }
DI unsigned xb_add(unsigned* p, unsigned v) { return __hip_atomic_fetch_add(p, v, __ATOMIC_RELAXED, __HIP_MEMORY_SCOPE_AGENT); }
DI unsigned xb_xcc_id() { return (unsigned)__builtin_amdgcn_s_getreg((3 << 11) | 20) & 0xFu; }
#define XB_SPIN(cond, bar) do { unsigned _sp = 0; while (cond) { __builtin_amdgcn_s_sleep(1); \
    if ((++_sp & 255u) == 0u) { if (xb_ld(&(bar)[XB_TMO])) break; if (_sp > XB_SPIN_CAP) { atomicAdd(&(bar)[XB_TMO], 1u); break; } } } } while (0)
struct XcdBarrier { unsigned* bar; unsigned x; volatile LAS unsigned* st; };
DI XcdBarrier xcd_barrier_post(unsigned* bar, volatile LAS unsigned* st) {
    XcdBarrier b; b.bar = bar; b.x = xb_xcc_id(); b.st = st;
    if (threadIdx.x == 0) (void)xb_add(&bar[XB_XCNT(b.x)], 1u);
    return b;
}
DI void xcd_barrier_complete(unsigned* bar, unsigned x, unsigned& nloc, unsigned& nx) {
    const unsigned G = gridDim.x * gridDim.y * gridDim.z;
    unsigned sum, cnt, mine, sp = 0u;
    for (;;) {
        sum = 0u; cnt = 0u; mine = 0u;
#pragma unroll
        for (unsigned j = 0; j < 16; ++j) { const unsigned c = xb_ld(&bar[XB_XCNT(j)]); sum += c; cnt += (c > 0u) ? 1u : 0u; mine = (j == x) ? c : mine; }
        if (sum == G) break;
        __builtin_amdgcn_s_sleep(1);
        if ((++sp & 255u) == 0u) { if (xb_ld(&bar[XB_TMO])) break; if (sp > XB_SPIN_CAP) { atomicAdd(&bar[XB_TMO], 1u); break; } }
    }
    nloc = mine > 0u ? mine : 1u; nx = cnt > 0u ? cnt : 1u;
}
DI void xcd_barrier(const XcdBarrier& b) {
    asm volatile("s_waitcnt vmcnt(0)" ::: "memory");
    __syncthreads();
    if (threadIdx.x == 0) {
        unsigned* bar = b.bar;
        __builtin_amdgcn_s_waitcnt(0);
        unsigned nloc = b.st[0], nx = b.st[1];
        if (nloc == 0u) { xcd_barrier_complete(bar, b.x, nloc, nx); b.st[0] = nloc; b.st[1] = nx; }
        const unsigned old = xb_add(&bar[XB_XSUB(b.x)], 1u);
        const unsigned gen = old / nloc;
        if (old + 1u == (gen + 1u) * nloc) {
            __builtin_amdgcn_fence(__ATOMIC_RELEASE, "agent");
            asm volatile("s_waitcnt vmcnt(0)" ::: "memory");
            const unsigned og = xb_add(&bar[XB_TOP], 1u);
            const unsigned tg = og / nx;
            if (og + 1u == (tg + 1u) * nx) xb_add(&bar[XB_TOPGEN], 1u);
            else XB_SPIN(xb_ld(&bar[XB_TOPGEN]) == tg, bar);
            __builtin_amdgcn_fence(__ATOMIC_ACQUIRE, "agent");
            xb_add(&bar[XB_XGEN(b.x)], 1u);
            asm volatile("s_waitcnt vmcnt(0)" ::: "memory");
        } else {
            XB_SPIN(xb_ld(&bar[XB_XGEN(b.x)]) == gen, bar);
            __builtin_amdgcn_fence(__ATOMIC_ACQUIRE, "agent");
            asm volatile("s_waitcnt vmcnt(0)" ::: "memory");
        }
    }
    __syncthreads();
}

struct Params {
    const float* in[30];
    float* out;
    unsigned char* ws;
    float inv_freq[16];
};

#define WSP(T_, off_) ((T_*)(p.ws + (off_)))
#define P_WGU WSP(bf16_t, WS_WGU)
#define P_WD WSP(bf16_t, WS_WD)
#define P_W3 WSP(bf16_t, WS_W3)
#define P_WUQT WSP(bf16_t, WS_WUQT)
#define P_WABST WSP(bf16_t, WS_WABST)
#define P_W5T WSP(bf16_t, WS_WUKT)
#define P_WOT WSP(bf16_t, WS_WOT)
#define P_WOVT WSP(bf16_t, WS_WOVT)
#define P_WKVT WSP(bf16_t, WS_WKVT)
#define P_WQST WSP(bf16_t, WS_WQST)
#define P_WOST WSP(bf16_t, WS_WOST)
#define P_ROPE WSP(float, WS_ROPE)
#define P_BT WSP(float, WS_BT)
#define P_XB WSP(bf16_t, WS_XB)
#define P_SSQX WSP(float, WS_SSQX)
#define P_SSQQ WSP(float, WS_SSQQ)
#define P_SSQL WSP(float, WS_SSQL)
#define P_SSQS WSP(float, WS_SSQS)
#define P_ACT WSP(bf16_t, WS_ACT)
#define P_QB WSP(bf16_t, WS_QB)
#define P_QS WSP(bf16_t, WS_QS)
#define P_CQB WSP(bf16_t, WS_CQB)
#define P_CKV WSP(float, WS_CKV)
#define P_LATB WSP(bf16_t, WS_LATB)
#define P_OB WSP(bf16_t, WS_OB)
#define P_QA WSP(bf16_t, WS_QA)
#define P_KNV WSP(bf16_t, WS_KNV)
#define P_KRB WSP(bf16_t, WS_KRB)
#define P_OA WSP(bf16_t, WS_OA)
#define P_KVSB WSP(bf16_t, WS_KVSB)
#define P_KS WSP(bf16_t, WS_KS)
#define P_KC WSP(bf16_t, WS_KC)
#define P_CTL WSP(unsigned, WS_CTL)

__global__ void __launch_bounds__(NTHREADS) yoco_fwd(Params p) {
    extern __shared__ __attribute__((aligned(16))) unsigned char lds_raw[];
    cg::grid_group grid = cg::this_grid();
    lds_u8* lds = (lds_u8*)lds_raw;
    const int G = gridDim.x, bid = blockIdx.x, NGW = G * NWAVES;
#define PHASE_IDS const int tid = otid(), lane = tid & 63, wave = __builtin_amdgcn_readfirstlane(tid >> 6), gw = bid * NWAVES + wave; (void)lane; (void)gw
    float* X = p.out;
    LAS int* slot = (LAS int*)(lds + LDS_SLOT);
    volatile LAS unsigned* bst = (volatile LAS unsigned*)(lds + LDS_SLOT + 16);
    if (threadIdx.x == 0) { bst[0] = 0u; bst[1] = 0u; }
    __syncthreads();
    const XcdBarrier xbar = xcd_barrier_post(P_CTL + 4096, bst);
#define GSYNC() xcd_barrier(xbar)

    {
        PHASE_IDS;
        LAS float* scr = (LAS float*)(lds + wave * 16640);
        {
            const int sgw = gw, SNGW = NGW;
            for (int row0 = sgw * 2; row0 < TT; row0 += SNGW * 2) {
                f32x4 v[2][4];
#pragma unroll
                for (int q = 0; q < 2; ++q) { const int row = row0 + q; const float* src = row < TP ? p.in[0] + (size_t)row * DM : p.in[1] + (size_t)(row - TP) * DM;
#pragma unroll
                    for (int j = 0; j < 4; ++j) v[q][j] = *(const f32x4*)(src + j * 256 + lane * 4); }
#pragma unroll
                for (int q = 0; q < 2; ++q) { const int row = row0 + q; float ss = 0.f;
#pragma unroll
                    for (int j = 0; j < 4; ++j) { const f32x4 t = v[q][j]; u32x2 w; w.x = pk2(t.x, t.y); w.y = pk2(t.z, t.w); *(u32x2*)(P_XB + (size_t)row * DM + j * 256 + lane * 4) = w; ss += (t.x * t.x + t.y * t.y) + (t.z * t.z + t.w * t.w); }
                    ss = wave_sum(ss);
                    if (row < TP) { if (lane < 16) P_SSQX[(size_t)row * 16 + lane] = (lane == 0) ? ss : 0.f; }
                    else if (lane < 32) P_SSQS[(size_t)(row - TP) * 32 + lane] = (lane == 0) ? ss : 0.f; }
            }
            {
                constexpr int I_F = 704, I_DQ = 96, I_UQ = 144, I_UK = 64, I_O = 256, I_KV = 128;
                constexpr int NIT = 12 * I_F + I_DQ + I_UQ + 2 * I_UK + 3 * I_O + I_KV;
                for (int it = sgw; it < NIT; it += SNGW) {
                    int rI = it;
                    const float* W; const float* gain = nullptr; bf16_t* WT; int N_, ldo, mode = 0;
                    if (rI < 12 * I_F) { const int m = rI / I_F; rI -= m * I_F; const int l = m / 6, t = m % 6, f = 2 * l + (t >= 3 ? 1 : 0), tt = t % 3;
                        if (tt == 2) { W = p.in[t == 2 ? 9 : 14] + (size_t)l * FF * DM; N_ = DM; WT = P_WD + (size_t)f * DM * FF; ldo = FF; }
                        else { W = p.in[(t >= 3 ? 12 : 7) + tt] + (size_t)l * DM * FF; N_ = FF; gain = p.in[t >= 3 ? 11 : 6] + l * DM; WT = P_WGU + (size_t)f * FF2 * DM; ldo = DM; mode = 1 + tt; }
                    } else { rI -= 12 * I_F;
                        if (rI < I_DQ) { W = p.in[15]; N_ = QL; gain = p.in[10]; WT = P_W3; ldo = DM; }
                        else if ((rI -= I_DQ) < I_UQ) { W = p.in[17]; N_ = 1536; gain = p.in[16]; WT = P_WUQT; ldo = QL; }
                        else if ((rI -= I_UQ) < I_UK) { W = p.in[20]; N_ = 1024; gain = p.in[19]; WT = P_W5T; ldo = KVL; mode = 3; }
                        else if ((rI -= I_UK) < I_UK) { W = p.in[21]; N_ = 1024; gain = p.in[19]; WT = P_W5T; ldo = KVL; mode = 4; }
                        else if ((rI -= I_UK) < I_O) { W = p.in[22]; N_ = DM; WT = P_WOT; ldo = DM; }
                        else if ((rI -= I_O) < I_KV) { W = p.in[24]; N_ = 512; gain = p.in[23]; WT = P_WKVT; ldo = DM; }
                        else if ((rI -= I_KV) < I_O) { W = p.in[25]; N_ = DM; gain = p.in[10] + DM; WT = P_WQST; ldo = DM; }
                        else { rI -= I_O; W = p.in[27]; N_ = DM; WT = P_WOST; ldo = DM; }
                    }
                    const int nblk = N_ / 64;
                    tr64_item(W, N_, gain, WT, ldo, mode, scr, rI / nblk, rI % nblk, lane);
                }
            }
            tr_matrix(p.in[18], DM, CKVW, p.in[10], P_W3, DM, 0, 384, scr, sgw, SNGW, lane);
            for (int i = sgw * 64 + lane; i < 96 * DM / 8; i += SNGW * 64) *(u32x4*)(P_W3 + (size_t)672 * DM + (size_t)i * 8) = (u32x4){0u, 0u, 0u, 0u};
            for (int rw = sgw; rw < 32 * 128; rw += SNGW) {
                const int b = rw >> 7, kk = rw & 127; bf16_t* dst = P_KS + ((size_t)b * 192 + kk) * 512;
                const f32x4 v = *(const f32x4*)(p.in[4] + (size_t)rw * 256 + lane * 4); u32x2 w; w.x = pk2(v.x, v.y); w.y = pk2(v.z, v.w); *(u32x2*)(dst + lane * 4) = w;
                const f32x4 q = *(const f32x4*)(p.in[5] + (size_t)rw * 256 + lane * 4); u32x2 w2; w2.x = pk2(q.x, q.y); w2.y = pk2(q.z, q.w); *(u32x2*)(dst + 256 + lane * 4) = w2;
            }
        }
        {
            const int cgw = gw, CNGW = NGW;
            for (int i = cgw * 64 + lane; i < KCL * 16; i += CNGW * 64) { const int pos = i >> 4, f = i & 15; const float ang = (float)pos * p.inv_freq[f];
                P_ROPE[(size_t)pos * 32 + f] = cosf(ang); P_ROPE[(size_t)pos * 32 + 16 + f] = sinf(ang); }
            for (int i = cgw * 64 + lane; i < 16 * 256; i += CNGW * 64) { const int hh = i >> 8, idx = i & 255; const int rel = idx - 191; const int n = rel < 0 ? -rel : rel;
                const float nf = (float)(n > 1 ? n : 1);
                int large = 8 + (int)(logf(nf / 8.0f) / 2.7725887298583984f * 8.0f); large = large < 15 ? large : 15;
                const int bucket = (rel > 0 ? 16 : 0) + (n < 8 ? n : large);
                P_BT[i] = p.in[28][bucket * 16 + hh] * LOG2E; }
            for (int it = cgw; it < 16 * 16 * 8; it += CNGW) {
                const int hh = it >> 7, nb = (it >> 3) & 15, cg_ = it & 7; const int n = nb * 64 + lane;
#pragma unroll
                for (int q = 0; q < 8; ++q) { const int idx = q * 64 + lane, cc = idx >> 4, j4 = idx & 15;
                    *(LAS f32x4*)(scr + cc * 64 + j4 * 4) = *(const f32x4*)(p.in[21] + (size_t)(cg_ * 32 + cc) * 1024 + hh * 64 + j4 * 4); }
                float bw[64];
                const float* bo = p.in[22] + (size_t)(hh * 64) * 1024 + n;
#pragma unroll
                for (int j = 0; j < 64; ++j) bw[j] = bo[(size_t)j * 1024];
                asm volatile("s_waitcnt lgkmcnt(0)" ::: "memory");
                for (int c8 = 0; c8 < 4; ++c8) {
                    float s[8];
#pragma unroll
                    for (int cc = 0; cc < 8; ++cc) { const LAS f32x4* av = (const LAS f32x4*)(scr + (c8 * 8 + cc) * 64); float acc = 0.f;
#pragma unroll
                        for (int j = 0; j < 16; ++j) { const f32x4 a4 = av[j]; acc += (bw[4 * j] * a4.x + bw[4 * j + 1] * a4.y) + (bw[4 * j + 2] * a4.z + bw[4 * j + 3] * a4.w); }
                        s[cc] = acc; }
                    u32x4 o; o.x = pk2(s[0], s[1]); o.y = pk2(s[2], s[3]); o.z = pk2(s[4], s[5]); o.w = pk2(s[6], s[7]);
                    *(u32x4*)(P_WOVT + (size_t)n * 4096 + hh * 256 + cg_ * 32 + c8 * 8) = o;
                }
                asm volatile("s_waitcnt lgkmcnt(0)" ::: "memory");
            }
            for (int it = cgw; it < 16 * 6 * 33; it += CNGW) {
                const int hh = it / 198, rem = it % 198, kb = rem / 33, cq = rem % 33; const int k = kb * 64 + lane;
                const float* aq = p.in[17] + (size_t)k * 1536 + hh * 96; const float gq = p.in[16][k];
                if (cq < 32) {
                    float a[64];
#pragma unroll
                    for (int j = 0; j < 16; ++j) { const f32x4 t = *(const f32x4*)(aq + 4 * j); a[4 * j] = t.x; a[4 * j + 1] = t.y; a[4 * j + 2] = t.z; a[4 * j + 3] = t.w; }
#pragma unroll
                    for (int cc = 0; cc < 8; ++cc) { const int c = cq * 8 + cc; const float* bk = p.in[20] + (size_t)c * 1024 + hh * 64; float s = 0.f;
#pragma unroll
                        for (int j = 0; j < 64; ++j) s += a[j] * bk[j];
                        P_WABST[(size_t)(hh * 288 + c) * QL + k] = f2bf(s * gq); }
                } else {
                    for (int rr = 0; rr < 32; ++rr) P_WABST[(size_t)(hh * 288 + 256 + rr) * QL + k] = f2bf(aq[64 + rr] * gq);
                }
            }
        }
    }
    grid.sync();

    pg8::StaticOrder S;
#define GEMM_UP(f) do { { pg8::Gemm g{P_XB, P_WGU + (size_t)(f) * FF2 * DM, DM, DM, DM}; S.init(TT, FF2, G, bid); pg8::EpiSwiGLU E{P_ACT, P_SSQX, P_SSQS}; pg8::gemm_phase(lds, g, S, E); } } while (0)
#define GEMM_DOWN(f) do { { pg8::Gemm g{P_ACT, P_WD + (size_t)(f) * DM * FF, FF, FF, FF}; S.init(TP, DM, G, bid); pg8::EpiResid E{(f) == 0 ? p.in[0] : X, X, P_XB, P_SSQX, 0.5f, 0}; pg8::gemm_phase(lds, g, S, E); } \
    { SEpiResid E2{(f) == 0 ? p.in[1] - (size_t)TP * DM : X, X, P_XB, P_SSQS, 0.5f}; sgemm64_phase(lds, P_ACT + (size_t)TP * FF, FF, P_WD + (size_t)(f) * DM * FF, FF, FF, DM / 64, G, bid, E2); } } while (0)

    GEMM_UP(0); GSYNC();
    GEMM_DOWN(0); GSYNC();
    { pg8::Gemm g{P_XB, P_W3, DM, DM, DM}; S.init(TP, 768, G, bid); pg8::EpiG3 E{P_SSQX, P_CQB, P_CKV, P_LATB, P_SSQQ, P_SSQL}; pg8::gemm_phase(lds, g, S, E); }
    { SEpiG3 E2{P_SSQS, P_CQB, P_CKV, P_SSQQ}; sgemm_phase(lds, P_XB + (size_t)TP * DM, DM, P_W3, DM, DM, 3, G, bid, E2); }
    GSYNC();
    {
        { PHASE_IDS;
        for (int row0 = gw * 2; row0 < TT; row0 += NGW * 2) {
            f32x4 vv[2]; float x1v[2], x2v[2];
#pragma unroll
            for (int q = 0; q < 2; ++q) { const float* ck = P_CKV + (size_t)(row0 + q) * CKVW; vv[q] = *(const f32x4*)(ck + lane * 4); x1v[q] = ck[256 + (lane & 15)]; x2v[q] = ck[272 + (lane & 15)]; }
#pragma unroll
            for (int q = 0; q < 2; ++q) {
            const int row = row0 + q; const f32x4 v = vv[q];
            const float ss = wave_sum((v.x * v.x + v.y * v.y) + (v.z * v.z + v.w * v.w)); const float rs = rsqrtf(ss * (1.0f / KVL) + RMS_EPS);
            const f32x4 gn = *(const f32x4*)(p.in[19] + lane * 4); const f32x4 o = v * rs * gn;
            const bool smp = row >= TP; const int sr = row - TP;
            *(f32x4*)(p.out + (smp ? O_LATS + (size_t)sr * 256 : O_LATP + (size_t)row * 256) + lane * 4) = o;
            const int pos = smp ? 4096 + (sr & 15) : (row & 4095);
            float kr = 0.f;
            if (lane < 32) { const int f = lane & 15; const float x1 = x1v[q], x2 = x2v[q];
                const float cs = P_ROPE[(size_t)pos * 32 + f], sn = P_ROPE[(size_t)pos * 32 + 16 + f];
                kr = lane < 16 ? x1 * cs - x2 * sn : x1 * sn + x2 * cs;
                p.out[(smp ? O_ROPES + (size_t)sr * 32 : O_ROPEP + (size_t)row * 32) + lane] = kr; }
            if (!smp && lane < 32) P_KRB[(size_t)row * 32 + lane] = f2bf(kr);
            }
        } }
        const float qscale = 0.10206207261596577f * LOG2E;
        { pg8::Gemm g{P_CQB, P_WUQT, QL, QL, QL}; S.init(TP, 1536, G, bid); pg8::EpiQ E{P_SSQQ, P_ROPE, P_QB, 1536, 0, 0, 3, 2, qscale}; pg8::gemm_phase(lds, g, S, E); }
        { SEpiQabs E2{P_SSQQ, P_ROPE, P_QA, qscale}; sgemm_phase(lds, P_CQB + (size_t)TP * QL, QL, P_WABST, QL, QL, 18, G, bid, E2); }
        { pg8::Gemm g{P_LATB, P_W5T, KVL, KVL, KVL}; S.init(TP, 2048, G, bid); pg8::EpiRowScale E{P_SSQL, 2, 1.0f / KVL, 1.0f, P_KNV, 2048}; pg8::gemm_phase(lds, g, S, E); }
    }
    GSYNC();
    {
        PHASE_IDS;
        for (;;) {
            __syncthreads(); if (tid == 0) *slot = (int)atomicAdd(P_CTL + 0, 1u); __syncthreads();
            const int u = *slot; if (u >= 64 + 1024) break;
            const int r = lane & 31;
            if (u < 64) {
                const int b = u >> 1, hf = u & 1, qb = wave & 3, dh = wave >> 2; const int head = hf * 8 + qb * 2 + (r >> 4), s = r & 15;
                flash_abs_unit(lds, P_QA + (size_t)(b * 16 + s) * 4608 + head * 288, p.in[2] + (size_t)b * 4096 * 256, p.in[3] + (size_t)b * 4096 * 32,
                    p.out + O_LATS + (size_t)b * 16 * 256, p.out + O_ROPES + (size_t)b * 16 * 32, dh * 128, P_OA + (size_t)(b * 16 + s) * 4096 + head * 256);
            } else {
                const int u2 = u - 64, i = 15 - (u2 >> 6), bh = u2 & 63, b = bh >> 4, hh = bh & 15; const int q = i * 256 + wave * 32 + r;
                flash_unit<96, 160, 4, 64, 64, 2, 2, false>(lds, P_QB + (size_t)(b * SEQ + q) * 1536 + hh * 96, P_KNV + (size_t)b * SEQ * 2048 + hh * 128, 2048, 16, P_KRB + (size_t)b * SEQ * 32, 32,
                    0, 0, 4 * (i + 1), 4 * i + (wave >> 1) + 1, 1 << 30, -1e30f, 0.f, (const LAS float*)lds, 0,
                    P_OB + (size_t)(b * SEQ + q) * DM + hh * 64, true);
            }
        }
    }
    GSYNC();
    { pg8::Gemm g{P_OB, P_WOT, DM, DM, DM}; S.init(TP, DM, G, bid); pg8::EpiResid E{X, X, P_XB, P_SSQX, 1.0f, 0}; pg8::gemm_phase(lds, g, S, E); }
    { SEpiResid E2{X, X, P_XB, P_SSQS, 1.0f}; sgemm64_phase(lds, P_OA, 4096, P_WOVT, 4096, 4096, 16, G, bid, E2); }
    GSYNC();
    GEMM_UP(1); GSYNC();
    GEMM_DOWN(1); GSYNC();
    { pg8::Gemm g{P_XB, P_WKVT, DM, DM, DM}; S.init(TT, 512, G, G - 1 - bid); pg8::EpiKV E{P_SSQX, P_KVSB, P_KS, p.out, P_SSQS}; pg8::gemm_phase(lds, g, S, E); }
    GEMM_UP(2); GSYNC();
    GEMM_DOWN(2); GSYNC();
    { pg8::Gemm g{P_XB, P_WQST, DM, DM, DM}; S.init(TP, DM, G, bid); pg8::EpiRowScale E{P_SSQX, 4, 1.0f / DM, 0.125f * LOG2E, P_QS, DM}; pg8::gemm_phase(lds, g, S, E); }
    { SEpiRowScale E2{P_SSQS, 0.125f * LOG2E, P_QS}; sgemm64_phase(lds, P_XB + (size_t)TP * DM, DM, P_WQST, DM, DM, 16, G, bid, E2); }
    GSYNC();
    {
        PHASE_IDS;
        LAS float* btab = (LAS float*)(lds + 40960);
        int g4_loaded = -1;
        for (int u = bid; u < 1024 + 128; u += G) {
            const int r = lane & 31;
            int b, g4, c; bool smp;
            if (u < 1024) { smp = false; b = u >> 8; c = (u >> 2) & 63; g4 = u & 3; } else { smp = true; const int v = u - 1024; b = v >> 2; g4 = v & 3; c = 64; }
            if (g4 != g4_loaded) { __syncthreads(); for (int i = tid; i < 1024; i += NTHREADS) btab[i] = P_BT[(g4 * 4 + (i >> 8)) * 256 + (i & 255)]; g4_loaded = g4; }
            const int hh = g4 * 4 + (wave >> 1);
            const float sink = p.in[26][hh] * LOG2E;
            if (!smp) {
                const int qi = (wave & 1) * 32 + r; const size_t qrow = (size_t)b * SEQ + c * 64 + qi; const int j0 = c >= 2 ? 0 : 2 - c;
                const bf16_t* kv = P_KVSB + ((long)b * SEQ + (c - 2) * 64) * 512 + g4 * 64;
                flash_unit<64, 128, 4, 0, 64, 2, 2, true>(lds, P_QS + qrow * DM + hh * 64, kv, 512, 8, kv + 256, 512,
                    0, j0, 3, 3, 1 << 30, sink, (lane >> 5) == 0 ? 1.f : 0.f,
                    btab + (wave >> 1) * 256, 63 - qi, P_OB + qrow * DM + hh * 64, true);
            } else {
                const int qi = r & 15; const size_t qrow = (size_t)TP + b * 16 + qi;
                const bf16_t* kv = P_KS + (size_t)b * 192 * 512 + g4 * 64;
                flash_unit<64, 128, 4, 0, 64, 2, 2, true>(lds, P_QS + qrow * DM + hh * 64, kv, 512, 8, kv + 256, 512,
                    0, 0, 3, (wave & 1) ? 0 : 3, 144, sink, (lane >> 5) == 0 ? 1.f : 0.f,
                    btab + (wave >> 1) * 256, 63 - qi, P_OB + qrow * DM + hh * 64, (wave & 1) == 0 && r < 16);
            }
        }
    }
    GSYNC();
    { pg8::Gemm g{P_OB, P_WOST, DM, DM, DM}; S.init(TP, DM, G, bid); pg8::EpiResid E{X, X, P_XB, P_SSQX, 1.0f, 0}; pg8::gemm_phase(lds, g, S, E); }
    { SEpiResid E2{X, X, P_XB, P_SSQS, 1.0f}; sgemm64_phase(lds, P_OB + (size_t)TP * DM, DM, P_WOST, DM, DM, 16, G, bid, E2); }
    GSYNC();
    GEMM_UP(3); GSYNC();
    GEMM_DOWN(3); GSYNC();
    { PHASE_IDS;
    for (int row0 = gw * 2; row0 < TT; row0 += NGW * 2) {
        f32x4 v[2][4];
#pragma unroll
        for (int q = 0; q < 2; ++q)
#pragma unroll
            for (int j = 0; j < 4; ++j) v[q][j] = *(const f32x4*)(X + (size_t)(row0 + q) * DM + j * 256 + lane * 4);
#pragma unroll
        for (int q = 0; q < 2; ++q) { float ss = 0.f;
#pragma unroll
            for (int j = 0; j < 4; ++j) ss += (v[q][j].x * v[q][j].x + v[q][j].y * v[q][j].y) + (v[q][j].z * v[q][j].z + v[q][j].w * v[q][j].w);
            const float rs = rsqrtf(wave_sum(ss) * (1.0f / DM) + RMS_EPS);
#pragma unroll
            for (int j = 0; j < 4; ++j) { const f32x4 gn = *(const f32x4*)(p.in[29] + j * 256 + lane * 4); *(f32x4*)(X + (size_t)(row0 + q) * DM + j * 256 + lane * 4) = v[q][j] * rs * gn; } }
    } }
}

extern "C" void kernel_launch(void* const* d_in, const int* in_sizes, int n_in, void* d_out, int out_size, void* d_ws, size_t ws_size, hipStream_t stream) {
    static int grid = 0;
    if (grid == 0) {
        if (n_in != 30 || ws_size < WS_END) { fprintf(stderr, "kernel_launch: n_in %d ws %zu (need %zu)\n", n_in, ws_size, (size_t)WS_END); grid = -1; return; }
        int dev = 0, cus = 0, per_cu = 0;
        hipGetDevice(&dev);
        hipDeviceGetAttribute(&cus, hipDeviceAttributeMultiprocessorCount, dev);
        hipFuncSetAttribute((const void*)yoco_fwd, hipFuncAttributeMaxDynamicSharedMemorySize, LDS_BYTES);
        hipOccupancyMaxActiveBlocksPerMultiprocessor(&per_cu, (const void*)yoco_fwd, NTHREADS, LDS_BYTES);
        if (per_cu < 1) per_cu = 1;
        grid = cus;
        (void)hipGetLastError();
    }
    if (grid < 0) return;
    (void)hipMemsetAsync((char*)d_ws + WS_CTL, 0, CTL_BYTES, stream);
    Params p{};
    for (int i = 0; i < 30; ++i) p.in[i] = (const float*)d_in[i];
    p.out = (float*)d_out; p.ws = (unsigned char*)d_ws;
    for (int i = 0; i < 16; ++i) p.inv_freq[i] = (float)pow(10000.0, -(double)(2 * i) / 32.0);
    void* args[] = {&p};
    hipError_t e = hipLaunchCooperativeKernel((const void*)yoco_fwd, dim3(grid), dim3(NTHREADS), args, LDS_BYTES, stream);
    if (e != hipSuccess) fprintf(stderr, "cooperative launch failed: %s (grid %d)\n", hipGetErrorString(e), grid);
}
```

```cpp
#include <hip/hip_runtime.h>
#include <hip/hip_cooperative_groups.h>
#include <cstdio>
#include <cstdint>
#include <cmath>
namespace cg = cooperative_groups;

#define DI __device__ __forceinline__
#define LAS __attribute__((address_space(3)))
typedef unsigned short bf16_t;
typedef short bf16x8 __attribute__((ext_vector_type(8)));
typedef short s16x4 __attribute__((ext_vector_type(4)));
typedef float f32x4 __attribute__((ext_vector_type(4)));
typedef float f32x16 __attribute__((ext_vector_type(16)));
typedef unsigned u32x4 __attribute__((ext_vector_type(4)));
typedef unsigned u32x2 __attribute__((ext_vector_type(2)));
typedef LAS unsigned char lds_u8;

constexpr int DM = 1024, TP = 16384, TS = 512, TT = TP + TS, SEQ = 4096;
constexpr int FF = 2816, FF2 = 5632;
constexpr int QL = 384, KVL = 256, CKVW = 288, QD = 96;
constexpr int KCL = 4112;
constexpr int NWAVES = 8, NTHREADS = 512;
constexpr int LDS_BYTES = 153600;
constexpr int LDS_SLOT = LDS_BYTES - 64;
constexpr float LOG2E = 1.4426950408889634f;
constexpr float RMS_EPS = 1e-6f;

constexpr size_t O_Y = 0;
constexpr size_t O_LATP = (size_t)TT * DM;
constexpr size_t O_ROPEP = O_LATP + (size_t)TP * 256;
constexpr size_t O_KP = O_ROPEP + (size_t)TP * 32;
constexpr size_t O_VP = O_KP + 4 * 128 * 256;
constexpr size_t O_LATS = O_VP + 4 * 128 * 256;
constexpr size_t O_ROPES = O_LATS + (size_t)TS * 256;
constexpr size_t O_KS = O_ROPES + (size_t)TS * 32;
constexpr size_t O_VS = O_KS + (size_t)TS * 256;

constexpr size_t al256(size_t x) { return (x + 255) & ~(size_t)255; }
constexpr size_t WS_CTL = 0, CTL_BYTES = 65536;
constexpr size_t WS_WGU = CTL_BYTES;
constexpr size_t WS_WD = WS_WGU + 4 * (size_t)FF2 * DM * 2;
constexpr size_t WS_W3 = WS_WD + 4 * (size_t)DM * FF * 2;
constexpr size_t WS_WUQT = WS_W3 + 768 * (size_t)DM * 2;
constexpr size_t WS_WABST = WS_WUQT + 1536 * (size_t)QL * 2;
constexpr size_t WS_WUKT = WS_WABST + 4608 * (size_t)QL * 2;
constexpr size_t WS_WUVT = WS_WUKT + 1024 * 256 * 2;
constexpr size_t WS_WOT = WS_WUVT + 1024 * 256 * 2;
constexpr size_t WS_WOVT = WS_WOT + (size_t)DM * DM * 2;
constexpr size_t WS_WKVT = WS_WOVT + (size_t)DM * 4096 * 2;
constexpr size_t WS_WQST = WS_WKVT + 512 * (size_t)DM * 2;
constexpr size_t WS_WOST = WS_WQST + (size_t)DM * DM * 2;
constexpr size_t WS_ROPE = WS_WOST + (size_t)DM * DM * 2;
constexpr size_t WS_BT = WS_ROPE + (size_t)KCL * 32 * 4;
constexpr size_t WS_XB = al256(WS_BT + 16 * 256 * 4);
constexpr size_t WS_SSQX = WS_XB + (size_t)TT * DM * 2;
constexpr size_t WS_SSQQ = WS_SSQX + (size_t)TT * 16 * 4;
constexpr size_t WS_SSQL = WS_SSQQ + (size_t)TT * 16 * 4;
constexpr size_t WS_SSQS = WS_SSQL + (size_t)TT * 16 * 4;
constexpr size_t WS_ACT = WS_SSQS + (size_t)TS * 32 * 4;
constexpr size_t WS_QB = WS_ACT;
constexpr size_t WS_QS = WS_ACT;
constexpr size_t WS_RB = WS_ACT + (size_t)TT * FF * 2;
constexpr size_t WS_CQB = WS_RB;
constexpr size_t WS_CKV = WS_CQB + (size_t)TT * QL * 2;
constexpr size_t WS_LATB = WS_CKV + (size_t)TT * CKVW * 4;
constexpr size_t WS_OB = WS_RB;
static_assert(WS_LATB + (size_t)TP * 256 * 2 >= WS_OB + (size_t)TT * DM * 2, "alias");
constexpr size_t WS_QA = WS_LATB + (size_t)TP * 256 * 2;
constexpr size_t WS_KNV = WS_QA + (size_t)TS * 4608 * 2;
constexpr size_t WS_KRB = WS_KNV + (size_t)TP * 2048 * 2;
constexpr size_t WS_OA = WS_KRB + (size_t)TP * 32 * 2;
constexpr size_t WS_KVSB = WS_OA + (size_t)TS * 4096 * 2;
constexpr size_t WS_KS = WS_KVSB + (size_t)TP * 512 * 2;
constexpr size_t WS_KC = WS_KS + (size_t)32 * 192 * 512 * 2;
constexpr size_t WS_END = WS_KC + (size_t)32 * KCL * CKVW * 2 + 65536;

DI unsigned pk2(float lo, float hi) {
    typedef float f2 __attribute__((ext_vector_type(2))); typedef __bf16 b2 __attribute__((ext_vector_type(2)));
    f2 v = {lo, hi}; b2 b = __builtin_convertvector(v, b2); return __builtin_bit_cast(unsigned, b);
}
DI unsigned short f2bf(float f) { return (unsigned short)(pk2(f, 0.f) & 0xffffu); }
DI float wave_sum(float v) {
#pragma unroll
    for (int o = 1; o < 64; o <<= 1) v += __shfl_xor(v, o);
    return v;
}
DI float row_rstd(const float* ssq, int row, int n4, float inv_dim) {
    const f32x4* p = (const f32x4*)(ssq + (size_t)row * 16);
    float s = 0.f;
    for (int i = 0; i < n4; ++i) { const f32x4 v = p[i]; s += (v.x + v.y) + (v.z + v.w); }
    return rsqrtf(s * inv_dim + RMS_EPS);
}
DI float srow_rstd(const float* ssqs, int rl) { const f32x4* p4 = (const f32x4*)(ssqs + (size_t)rl * 32); float s = 0.f;
#pragma unroll
    for (int i = 0; i < 8; ++i) { const f32x4 v = p4[i]; s += (v.x + v.y) + (v.z + v.w); }
    return rsqrtf(s * (1.0f / DM) + RMS_EPS); }
DI int otid() { int t = threadIdx.x; asm volatile("" : "+v"(t)); return t; }
DI float halfmax(float m) { auto rr = __builtin_amdgcn_permlane32_swap(__float_as_uint(m), __float_as_uint(m), false, false); return fmaxf(__uint_as_float(rr[0]), __uint_as_float(rr[1])); }
DI int crow(int i, int h) { return (i & 3) + 8 * (i >> 2) + 4 * h; }
#define MFMA32(a, b, c) __builtin_amdgcn_mfma_f32_32x32x16_bf16((a), (b), (c), 0, 0, 0)

namespace pg8 {
constexpr int BM = 256, BK = 64, HALF = 128, HTB = HALF * BK * 2, STAGE_BYTES = 8 * HTB, NXCD = 8, WGM = 8;
__host__ __device__ __forceinline__ int lds_byte(int r, int c) { const int st = (r >> 4) * 2 + (c >> 5), rr = r & 15, cc = c & 31, ob = rr * 64 + cc * 2; return st * 1024 + (ob ^ (((ob >> 9) & 1) << 5)); }
__host__ __device__ __forceinline__ void stage_rc(int b, int& R, int& C) { const int st = b / 1024, sb = b % 1024, swz = sb ^ (((sb >> 9) & 1) << 5); R = (st >> 1) * 16 + swz / 64; C = (st & 1) * 32 + (swz % 64) / 2; }
__host__ __device__ __forceinline__ int perm32(int rho) { const int n = rho >> 4, i = rho & 15; return 8 * (i >> 2) + 4 * n + (i & 3); }

struct Unit { int pm, pn; };
struct Gemm { const bf16_t* A; const bf16_t* Bt; int lda, ldb, K; };

struct StaticOrder {
    int nM, nN, nwg, G, c;
    __device__ void init(int M, int N, int G_, int c_) { nM = M / BM; nN = N / BM; nwg = nM * nN; G = G_; c = c_; }
    __device__ bool next(int i, Unit& u) const {
        const long L = (long)i * G + c; if (L >= nwg) return false;
        int wgid = (int)L; { const int q = nwg / NXCD, r = nwg % NXCD, xcd = wgid % NXCD, off = wgid / NXCD; wgid = (xcd < r ? xcd * (q + 1) : r * (q + 1) + (xcd - r) * q) + off; }
        const int nig = WGM * nN, gid = wgid / nig, fm = gid * WGM, gsz = (nM - fm) < WGM ? (nM - fm) : WGM;
        u.pm = fm + ((wgid % nig) % gsz); u.pn = (wgid % nig) / gsz; return true;
    }
};

template <class Epi>
__device__ __forceinline__ void gemm_phase(lds_u8* lds, const Gemm g, const StaticOrder& S, const Epi& E) {
    const int tid = otid(), wid = __builtin_amdgcn_readfirstlane(tid >> 6), lane = tid & 63, wr = wid >> 2, wc = wid & 3, fr = lane & 15, fq = lane >> 4;
    const int K = g.K, nt = K / BK;
    unsigned voffA[2], voffB[2];
#pragma unroll
    for (int i = 0; i < 2; ++i) { int R, C; stage_rc(tid * 16 + i * 8192, R, C); const int Rb = Epi::PERM ? ((R & ~31) + perm32(R & 31)) : R;
        voffA[i] = (unsigned)(R * g.lda + C) * 2u; voffB[i] = (unsigned)(Rb * g.ldb + C) * 2u; }
    const size_t kstep = (size_t)(BK * 2);
    const size_t hstepA = (size_t)HALF * g.lda * 2, hstepB = (size_t)HALF * g.ldb * 2;
    const size_t tstepA = 2 * hstepA, tstepB = 2 * hstepB;
    const unsigned ldsw = (unsigned)wid * 1024u;
    const int aoff = lds_byte(wr * 64 + fr, fq * 8), boff = lds_byte(wc * 32 + fr, fq * 8);
#define PG8_SA(b, h) (((b) * 2 + (h)) * HTB)
#define PG8_SB(b, h) ((4 + (b) * 2 + (h)) * HTB)
#define PG8_STAGE(bufoff, gbase, voff) do { _Pragma("unroll") for (int _i = 0; _i < 2; ++_i) \
        __builtin_amdgcn_global_load_lds((const unsigned*)((const char*)(gbase) + (voff)[_i]), (LAS unsigned*)(lds + (bufoff) + ldsw + _i * 8192), 16, 0, 0); } while (0)
#define PG8_LDA(dst, b, h) do { _Pragma("unroll") for (int m = 0; m < 4; ++m) _Pragma("unroll") for (int k = 0; k < 2; ++k) dst[m][k] = *(const LAS bf16x8*)(lds + PG8_SA(b, h) + aoff + m * 2048 + k * 1024); } while (0)
#define PG8_LDB(dst, b, h) do { _Pragma("unroll") for (int n = 0; n < 2; ++n) _Pragma("unroll") for (int k = 0; k < 2; ++k) dst[n][k] = *(const LAS bf16x8*)(lds + PG8_SB(b, h) + boff + n * 2048 + k * 1024); } while (0)
#define PG8_MMA(ai, bj, At, Bt) do { __builtin_amdgcn_s_setprio(1); _Pragma("unroll") for (int m = 0; m < 4; ++m) _Pragma("unroll") for (int n = 0; n < 2; ++n) _Pragma("unroll") for (int k = 0; k < 2; ++k) \
        acc[ai][bj][m][n] = __builtin_amdgcn_mfma_f32_16x16x32_bf16(Bt[n][k], At[m][k], acc[ai][bj][m][n], 0, 0, 0); __builtin_amdgcn_s_setprio(0); } while (0)
#define PG8_WAIT_V(n) asm volatile("s_waitcnt vmcnt(" #n ")" ::: "memory")
#define PG8_WAIT_L(n) asm volatile("s_waitcnt lgkmcnt(" #n ")" ::: "memory")
#define PG8_BAR __builtin_amdgcn_s_barrier()
#define PG8_SCHED __builtin_amdgcn_sched_barrier(0)
    Unit cur, nxt; int ui = 0;
    if (!S.next(0, cur)) return;
    f32x4 acc[2][2][4][2];
#pragma unroll
    for (int a = 0; a < 2; ++a)
#pragma unroll
        for (int b = 0; b < 2; ++b)
#pragma unroll
            for (int m = 0; m < 4; ++m)
#pragma unroll
                for (int n = 0; n < 2; ++n) acc[a][b][m][n] = (f32x4){0.f, 0.f, 0.f, 0.f};
    bf16x8 At[4][2], B0[2][2], B1[2][2];
    const char* cA = (const char*)g.A + (size_t)cur.pm * tstepA; const char* cB = (const char*)g.Bt + (size_t)cur.pn * tstepB;
    PG8_STAGE(PG8_SB(0, 0), cB, voffB); PG8_STAGE(PG8_SB(0, 1), cB + hstepB, voffB); PG8_STAGE(PG8_SA(0, 0), cA, voffA); PG8_STAGE(PG8_SA(0, 1), cA + hstepA, voffA);
    if (wr == 1) PG8_BAR;
    PG8_WAIT_V(2); PG8_BAR;
    PG8_STAGE(PG8_SB(1, 0), cB + kstep, voffB); PG8_STAGE(PG8_SA(1, 0), cA + kstep, voffA); PG8_STAGE(PG8_SB(1, 1), cB + hstepB + kstep, voffB);
    PG8_WAIT_V(6); PG8_BAR;
    for (;;) {
        const bool has_next = S.next(ui + 1, nxt);
        const char* nA = has_next ? (const char*)g.A + (size_t)nxt.pm * tstepA : cA; const char* nB = has_next ? (const char*)g.Bt + (size_t)nxt.pn * tstepB : cB;
        for (int t = 0; t < nt; t += 2) {
            const bool last = (t == nt - 2);
            const char* a1 = cA + (size_t)(t + 1) * kstep;
            const char* a2 = last ? nA : cA + (size_t)(t + 2) * kstep; const char* b2 = last ? nB : cB + (size_t)(t + 2) * kstep;
            const char* a3 = a2 + kstep; const char* b3 = b2 + kstep;
            PG8_LDB(B0, 0, 0); PG8_LDB(B1, 0, 1); PG8_SCHED; PG8_LDA(At, 0, 0); PG8_STAGE(PG8_SA(1, 1), a1 + hstepA, voffA);
            PG8_WAIT_V(8); PG8_WAIT_L(0); PG8_BAR; PG8_MMA(0, 0, At, B0); PG8_MMA(0, 1, At, B1); PG8_BAR; PG8_SCHED;
            PG8_LDA(At, 0, 1); PG8_STAGE(PG8_SB(0, 0), b2, voffB); PG8_STAGE(PG8_SB(0, 1), b2 + hstepB, voffB); PG8_STAGE(PG8_SA(0, 0), a2, voffA);
            PG8_WAIT_V(8); PG8_WAIT_L(0); PG8_BAR; PG8_MMA(1, 0, At, B0); PG8_MMA(1, 1, At, B1); PG8_BAR; PG8_SCHED;
            PG8_LDB(B0, 1, 0); PG8_LDB(B1, 1, 1); PG8_SCHED; PG8_LDA(At, 1, 0); PG8_STAGE(PG8_SA(0, 1), a2 + hstepA, voffA);
            PG8_WAIT_V(8); PG8_WAIT_L(0); PG8_BAR; PG8_MMA(0, 0, At, B0); PG8_MMA(0, 1, At, B1); PG8_BAR; PG8_SCHED;
            PG8_LDA(At, 1, 1); PG8_STAGE(PG8_SB(1, 0), b3, voffB); PG8_STAGE(PG8_SB(1, 1), b3 + hstepB, voffB); PG8_STAGE(PG8_SA(1, 0), a3, voffA);
            PG8_WAIT_V(8); PG8_WAIT_L(0); PG8_BAR; PG8_MMA(1, 0, At, B0); PG8_MMA(1, 1, At, B1); PG8_BAR; PG8_SCHED;
        }
        if (wr == 0) PG8_BAR;
        { const int l2 = otid() & 63; E(acc, cur, wr, wc, l2 & 15, l2 >> 4); }
        if (!has_next) break;
#pragma unroll
        for (int a = 0; a < 2; ++a)
#pragma unroll
            for (int b = 0; b < 2; ++b)
#pragma unroll
                for (int m = 0; m < 4; ++m)
#pragma unroll
                    for (int n = 0; n < 2; ++n) acc[a][b][m][n] = (f32x4){0.f, 0.f, 0.f, 0.f};
        cur = nxt; cA = nA; cB = nB; ++ui;
        if (wr == 1) PG8_BAR;
    }
    PG8_WAIT_V(0);
    PG8_BAR;
#undef PG8_SA
#undef PG8_SB
#undef PG8_STAGE
#undef PG8_LDA
#undef PG8_LDB
#undef PG8_MMA
#undef PG8_WAIT_V
#undef PG8_WAIT_L
#undef PG8_BAR
#undef PG8_SCHED
}

typedef const f32x4 (&AccRef)[2][2][4][2];
DI void unit_rstd(float (&rs)[2][4], const float* ssq, int rowbase, int n4, float inv_dim, float mul) {
    const int L = otid() & 63; float own[2]; f32x4 t[2][4];
#pragma unroll
    for (int ai = 0; ai < 2; ++ai)
#pragma unroll
        for (int i = 0; i < 4; ++i) t[ai][i] = (i < n4) ? *(const f32x4*)(ssq + (size_t)(rowbase + ai * HALF + L) * 16 + 4 * i) : (f32x4){0.f, 0.f, 0.f, 0.f};
#pragma unroll
    for (int ai = 0; ai < 2; ++ai) { float s = 0.f;
#pragma unroll
        for (int i = 0; i < 4; ++i) s += (t[ai][i].x + t[ai][i].y) + (t[ai][i].z + t[ai][i].w);
        own[ai] = rsqrtf(s * inv_dim + RMS_EPS) * mul; }
#pragma unroll
    for (int ai = 0; ai < 2; ++ai)
#pragma unroll
        for (int m = 0; m < 4; ++m) rs[ai][m] = __shfl(own[ai], m * 16 + (L & 15));
}
DI void unit_rstd_s(float (&rs)[2][4], const float* ssqs, int rlbase, float mul) {
    const int L = otid() & 63; float own[2];
#pragma unroll
    for (int ai = 0; ai < 2; ++ai) { f32x4 t[8]; float s = 0.f;
#pragma unroll
        for (int i = 0; i < 8; ++i) t[i] = *(const f32x4*)(ssqs + (size_t)(rlbase + ai * HALF + L) * 32 + 4 * i);
#pragma unroll
        for (int i = 0; i < 8; ++i) s += (t[i].x + t[i].y) + (t[i].z + t[i].w);
        own[ai] = rsqrtf(s * (1.0f / DM) + RMS_EPS) * mul; asm volatile("" ::: "memory"); }
#pragma unroll
    for (int ai = 0; ai < 2; ++ai)
#pragma unroll
        for (int m = 0; m < 4; ++m) rs[ai][m] = __shfl(own[ai], m * 16 + (L & 15));
}
struct EpiSwiGLU {
    static constexpr bool PERM = true;
    bf16_t* O; const float* ssq; const float* ssqs;
    DI void operator()(AccRef acc, const Unit& u, int wr, int wc, int fr, int fq) const {
        const int row0 = u.pm * BM + wr * 64 + fr, col0 = u.pn * 128 + wc * 32 + 8 * fq;
        float rsv[2][4];
        if (u.pm * BM >= TP) unit_rstd_s(rsv, ssqs, u.pm * BM - TP + wr * 64, 1.0f); else unit_rstd(rsv, ssq, u.pm * BM + wr * 64, 4, 1.0f / DM, 1.0f);
#pragma unroll
        for (int ai = 0; ai < 2; ++ai)
#pragma unroll
            for (int m = 0; m < 4; ++m) {
                const int row = row0 + ai * HALF + m * 16; const float rs = rsv[ai][m];
                float o[8];
#pragma unroll
                for (int n = 0; n < 2; ++n)
#pragma unroll
                    for (int j = 0; j < 4; ++j) { const float gt = acc[ai][0][m][n][j] * rs, up = acc[ai][1][m][n][j] * rs;
                        const float sg = gt * __builtin_amdgcn_rcpf(1.0f + __builtin_amdgcn_exp2f(-gt * LOG2E)); o[n * 4 + j] = sg * up; }
                u32x4 w; w.x = pk2(o[0], o[1]); w.y = pk2(o[2], o[3]); w.z = pk2(o[4], o[5]); w.w = pk2(o[6], o[7]);
                *(u32x4*)(O + (size_t)row * FF + col0) = w;
            }
    }
};
struct EpiResid {
    static constexpr bool PERM = true;
    const float* Xin; float* X; bf16_t* XB; float* ssq; float scale; int row_base;
    DI void operator()(AccRef acc, const Unit& u, int wr, int wc, int fr, int fq) const {
        const int row0 = row_base + u.pm * BM + wr * 64 + fr, col0 = u.pn * BM + wc * 32 + 8 * fq;
#pragma unroll
        for (int ai = 0; ai < 2; ++ai) {
            f32x4 xo[4][2][2];
#pragma unroll
            for (int m = 0; m < 4; ++m)
#pragma unroll
                for (int bj = 0; bj < 2; ++bj)
#pragma unroll
                    for (int n = 0; n < 2; ++n) xo[m][bj][n] = *(const f32x4*)(Xin + (size_t)(row0 + ai * HALF + m * 16) * DM + col0 + bj * HALF + n * 4);
#pragma unroll
            for (int m = 0; m < 4; ++m) {
                const int row = row0 + ai * HALF + m * 16; float ss = 0.f;
#pragma unroll
                for (int bj = 0; bj < 2; ++bj) { const size_t off = (size_t)row * DM + col0 + bj * HALF;
                    const f32x4 x0 = xo[m][bj][0] + acc[ai][bj][m][0] * scale, x1 = xo[m][bj][1] + acc[ai][bj][m][1] * scale;
                    *(f32x4*)(X + off) = x0; *(f32x4*)(X + off + 4) = x1;
                    u32x4 w; w.x = pk2(x0.x, x0.y); w.y = pk2(x0.z, x0.w); w.z = pk2(x1.x, x1.y); w.w = pk2(x1.z, x1.w); *(u32x4*)(XB + off) = w;
                    ss += ((x0.x * x0.x + x0.y * x0.y) + (x0.z * x0.z + x0.w * x0.w)) + ((x1.x * x1.x + x1.y * x1.y) + (x1.z * x1.z + x1.w * x1.w)); }
                ss += __shfl_xor(ss, 16); ss += __shfl_xor(ss, 32);
                if (fq == 0) ssq[(size_t)row * 16 + u.pn * 4 + wc] = ss;
            }
            asm volatile("" ::: "memory");
        }
    }
};
struct EpiG3 {
    static constexpr bool PERM = false;
    const float* ssqx; bf16_t* CQB; float* CKV; bf16_t* LATB; float* ssqq; float* ssql;
    DI void operator()(AccRef acc, const Unit& u, int wr, int wc, int fr, int fq) const {
        const int row0 = u.pm * BM + wr * 64 + fr;
        float rsv[2][4]; unit_rstd(rsv, ssqx, u.pm * BM + wr * 64, 4, 1.0f / DM, 1.0f);
#pragma unroll
        for (int ai = 0; ai < 2; ++ai)
#pragma unroll
            for (int m = 0; m < 4; ++m) {
                const int row = row0 + ai * HALF + m * 16; const float rs = rsv[ai][m];
#pragma unroll
                for (int bj = 0; bj < 2; ++bj) {
                    const int reg = u.pn * 2 + bj;
                    const f32x4 v0 = acc[ai][bj][m][0] * rs, v1 = acc[ai][bj][m][1] * rs;
                    const int c0 = reg * 128 + wc * 32 + 4 * fq;
                    if (reg < 5) {
                        float ss = (v0.x * v0.x + v0.y * v0.y) + (v0.z * v0.z + v0.w * v0.w) + (v1.x * v1.x + v1.y * v1.y) + (v1.z * v1.z + v1.w * v1.w);
                        ss += __shfl_xor(ss, 16); ss += __shfl_xor(ss, 32);
                        if (reg < 3) {
                            u32x2 w0, w1; w0.x = pk2(v0.x, v0.y); w0.y = pk2(v0.z, v0.w); w1.x = pk2(v1.x, v1.y); w1.y = pk2(v1.z, v1.w);
                            *(u32x2*)(CQB + (size_t)row * QL + c0) = w0; *(u32x2*)(CQB + (size_t)row * QL + c0 + 16) = w1;
                            if (fq == 0) ssqq[(size_t)row * 16 + reg * 4 + wc] = ss;
                        } else {
                            const int lc = c0 - 384;
                            *(f32x4*)(CKV + (size_t)row * CKVW + lc) = v0; *(f32x4*)(CKV + (size_t)row * CKVW + lc + 16) = v1;
                            if (row < TP) { u32x2 w0, w1; w0.x = pk2(v0.x, v0.y); w0.y = pk2(v0.z, v0.w); w1.x = pk2(v1.x, v1.y); w1.y = pk2(v1.z, v1.w);
                                *(u32x2*)(LATB + (size_t)row * 256 + lc) = w0; *(u32x2*)(LATB + (size_t)row * 256 + lc + 16) = w1; }
                            if (fq == 0) ssql[(size_t)row * 16 + (reg - 3) * 4 + wc] = ss;
                        }
                    } else if (wc == 0) {
                        *(f32x4*)(CKV + (size_t)row * CKVW + 256 + 4 * fq) = v0; *(f32x4*)(CKV + (size_t)row * CKVW + 272 + 4 * fq) = v1;
                    }
                }
            }
    }
};
struct EpiQ {
    static constexpr bool PERM = false;
    const float* ssqq; const float* rope; bf16_t* O; int ldo, row_base, sample, mod, rem; float qscale;
    DI void operator()(AccRef acc, const Unit& u, int wr, int wc, int fr, int fq) const {
        const int row0 = u.pm * BM + wr * 64 + fr;
        float rsv[2][4]; unit_rstd(rsv, ssqq, row_base + u.pm * BM + wr * 64, 3, 1.0f / QL, qscale);
#pragma unroll
        for (int ai = 0; ai < 2; ++ai)
#pragma unroll
            for (int m = 0; m < 4; ++m) {
                const int rl = row0 + ai * HALF + m * 16; const float rs = rsv[ai][m];
                const int pos = sample ? 4096 + (rl & 15) : (rl & 4095);
#pragma unroll
                for (int bj = 0; bj < 2; ++bj) {
                    const int g32 = u.pn * 8 + bj * 4 + wc;
                    f32x4 v0 = acc[ai][bj][m][0] * rs, v1 = acc[ai][bj][m][1] * rs;
                    if (g32 % mod == rem) { const f32x4 cs = *(const f32x4*)(rope + (size_t)pos * 32 + 4 * fq), sn = *(const f32x4*)(rope + (size_t)pos * 32 + 16 + 4 * fq);
                        const f32x4 o0 = v0 * cs - v1 * sn, o1 = v0 * sn + v1 * cs; v0 = o0; v1 = o1; }
                    const size_t off = (size_t)rl * ldo + g32 * 32 + 4 * fq;
                    u32x2 w0, w1; w0.x = pk2(v0.x, v0.y); w0.y = pk2(v0.z, v0.w); w1.x = pk2(v1.x, v1.y); w1.y = pk2(v1.z, v1.w);
                    *(u32x2*)(O + off) = w0; *(u32x2*)(O + off + 16) = w1;
                }
            }
    }
};
struct EpiRowScale {
    static constexpr bool PERM = true;
    const float* ssq; int n4; float inv_dim, oscale; bf16_t* O; int ldo;
    DI void operator()(AccRef acc, const Unit& u, int wr, int wc, int fr, int fq) const {
        const int row0 = u.pm * BM + wr * 64 + fr, col0 = u.pn * BM + wc * 32 + 8 * fq;
        float rsv[2][4]; unit_rstd(rsv, ssq, u.pm * BM + wr * 64, n4, inv_dim, oscale);
#pragma unroll
        for (int ai = 0; ai < 2; ++ai)
#pragma unroll
            for (int m = 0; m < 4; ++m) {
                const int row = row0 + ai * HALF + m * 16; const float rs = rsv[ai][m];
#pragma unroll
                for (int bj = 0; bj < 2; ++bj) { const f32x4 v0 = acc[ai][bj][m][0] * rs, v1 = acc[ai][bj][m][1] * rs;
                    u32x4 w; w.x = pk2(v0.x, v0.y); w.y = pk2(v0.z, v0.w); w.z = pk2(v1.x, v1.y); w.w = pk2(v1.z, v1.w);
                    *(u32x4*)(O + (size_t)row * ldo + col0 + bj * HALF) = w; }
            }
    }
};
struct EpiKV {
    static constexpr bool PERM = false;
    const float* ssqx; bf16_t* KVSB; bf16_t* KS; float* out; const float* ssqs;
    DI void operator()(AccRef acc, const Unit& u, int wr, int wc, int fr, int fq) const {
        const int row0 = u.pm * BM + wr * 64 + fr; const bool isv = (u.pn == 1);
        float rsv[2][4];
        if (u.pm * BM >= TP) unit_rstd_s(rsv, ssqs, u.pm * BM - TP + wr * 64, 1.0f); else unit_rstd(rsv, ssqx, u.pm * BM + wr * 64, 4, 1.0f / DM, 1.0f);
#pragma unroll
        for (int ai = 0; ai < 2; ++ai)
#pragma unroll
            for (int m = 0; m < 4; ++m) {
                const int row = row0 + ai * HALF + m * 16; const float rs = rsv[ai][m];
                const bool smp = row >= TP; const int b = smp ? (row - TP) >> 4 : row >> 12, pos = smp ? (row - TP) & 15 : row & 4095;
#pragma unroll
                for (int bj = 0; bj < 2; ++bj)
#pragma unroll
                    for (int n = 0; n < 2; ++n) {
                        const f32x4 v = acc[ai][bj][m][n] * rs; const int c = bj * HALF + wc * 32 + n * 16 + 4 * fq;
                        if (smp) *(f32x4*)(out + (isv ? O_VS : O_KS) + (size_t)(row - TP) * 256 + c) = v;
                        else if (pos >= SEQ - 128) *(f32x4*)(out + (isv ? O_VP : O_KP) + ((size_t)b * 128 + (pos - (SEQ - 128))) * 256 + c) = v;
                        u32x2 w; w.x = pk2(v.x, v.y); w.y = pk2(v.z, v.w);
                        if (smp) *(u32x2*)(KS + ((size_t)b * 192 + 128 + pos) * 512 + u.pn * 256 + c) = w;
                        else *(u32x2*)(KVSB + (size_t)row * 512 + u.pn * 256 + c) = w;
                    }
            }
    }
};
}

typedef short v4i16_t __attribute__((ext_vector_type(4)));
DI s16x4 tr16(const lds_u8* p) { return __builtin_bit_cast(s16x4, __builtin_amdgcn_ds_read_tr16_b64_v4i16((LAS v4i16_t*)p)); }

template <int DQK, int DROW, int KSPLIT, int KGAP, int VOFF, int NDB, int NBLK, bool BIAS>
DI void flash_unit(lds_u8* lds, const bf16_t* qrow, const bf16_t* kA, int pitchA, int da8, const bf16_t* kB, int pitchB,
                   int dofs, int j0, int ntiles, int my_tiles, int kvlimit,
                   float m_init, float l_init, const LAS float* bias_tab, int bias_off, bf16_t* orow, bool store_ok) {
    constexpr int CPR = DROW / 8, ROWB = DROW * 2 + 16, TILEB = 64 * ROWB;
    constexpr int NCH = 64 * CPR, NKR = (NCH + 511) / 512, ND0 = DQK / 16;
    const int tid = otid(), lane = tid & 63, r = lane & 31, h = lane >> 5;
    bf16x8 qf[ND0];
#pragma unroll
    for (int d0 = 0; d0 < ND0; ++d0) qf[d0] = *(const bf16x8*)(qrow + 16 * d0 + 8 * h);
    f32x16 O[NDB];
#pragma unroll
    for (int d = 0; d < NDB; ++d)
#pragma unroll
        for (int i = 0; i < 16; ++i) O[d][i] = 0.f;
    float mrun = m_init, lrun = l_init;
    u32x4 kreg[3][NKR];
    const u32x4 zero4 = {0u, 0u, 0u, 0u};
#define FL_LOAD(st, jt) do { const int kv0_ = (jt) * 64; \
    _Pragma("unroll") for (int i_ = 0; i_ < NKR; ++i_) { const int c_ = tid + i_ * 512; if ((NCH % 512 == 0) || c_ < NCH) { const int row_ = c_ / CPR, cc_ = c_ % CPR, kv_ = kv0_ + row_; \
        const bf16_t* s_ = (cc_ < da8) ? kA + (size_t)kv_ * pitchA + cc_ * 8 : kB + (size_t)kv_ * pitchB + (cc_ - da8) * 8; \
        kreg[st][i_] = (kv_ < kvlimit) ? *(const u32x4*)s_ : zero4; } } } while (0)
#define FL_STORE(st, buf) do { \
    _Pragma("unroll") for (int i_ = 0; i_ < NKR; ++i_) { const int c_ = tid + i_ * 512; if ((NCH % 512 == 0) || c_ < NCH) { const int row_ = c_ / CPR, cc_ = c_ % CPR; \
        *(LAS u32x4*)(lds + (buf) * TILEB + row_ * ROWB + cc_ * 16) = kreg[st][i_]; } } } while (0)
    const int nt = ntiles - j0;
    FL_LOAD(0, j0); if (nt > 1) FL_LOAD(1, j0 + 1); if (nt > 2) FL_LOAD(2, j0 + 2);
    FL_STORE(0, 0); if (nt > 3) FL_LOAD(0, j0 + 3); __syncthreads();
    const int vlane = (4 * h + ((lane & 15) >> 2)) * ROWB + (VOFF + dofs + 16 * ((lane >> 4) & 1) + 4 * (lane & 3)) * 2;
    for (int t0 = 0; t0 < nt; t0 += 3) {
#pragma unroll
      for (int s3 = 0; s3 < 3; ++s3) {
        const int t = t0 + s3;
        if (t < nt) {
        const int j = j0 + t, buf = t & 1;
        if (j < my_tiles) {
            const lds_u8* Kt = lds + buf * TILEB;
#pragma unroll
            for (int ss = 0; ss < 2; ss += NBLK) {
                f32x16 S[NBLK];
#pragma unroll
                for (int b = 0; b < NBLK; ++b) {
#pragma unroll
                    for (int i = 0; i < 16; ++i) S[b][i] = 0.f;
                    const lds_u8* kp = Kt + ((ss + b) * 32 + r) * ROWB + h * 16;
#pragma unroll
                    for (int d0 = 0; d0 < ND0; ++d0) { const bf16x8 kf = *(const LAS bf16x8*)(kp + (16 * d0 + (d0 >= KSPLIT ? KGAP : 0)) * 2); S[b] = MFMA32(kf, qf[d0], S[b]); }
                }
                if (BIAS) {
#pragma unroll
                    for (int b = 0; b < NBLK; ++b)
#pragma unroll
                        for (int i = 0; i < 16; ++i) S[b][i] += bias_tab[j * 64 + (ss + b) * 32 + crow(i, h) + bias_off];
                }
                if (j * 64 + 64 > kvlimit) {
#pragma unroll
                    for (int b = 0; b < NBLK; ++b)
#pragma unroll
                        for (int i = 0; i < 16; ++i) if (j * 64 + (ss + b) * 32 + crow(i, h) >= kvlimit) S[b][i] = -1e30f;
                }
                float mt = S[0][0];
#pragma unroll
                for (int b = 0; b < NBLK; ++b)
#pragma unroll
                    for (int i = 0; i < 16; ++i) mt = fmaxf(mt, S[b][i]);
                mt = halfmax(mt);
                if (__any(mt > mrun)) {
                    const float mn0 = fmaxf(mrun, mt); const float alpha = __builtin_amdgcn_exp2f(mrun - mn0); mrun = mn0; lrun *= alpha;
#pragma unroll
                    for (int d = 0; d < NDB; ++d)
#pragma unroll
                        for (int i = 0; i < 16; ++i) O[d][i] *= alpha;
                }
                const float mn = mrun;
                float ps = 0.f;
#pragma unroll
                for (int b = 0; b < NBLK; ++b)
#pragma unroll
                    for (int i = 0; i < 16; ++i) { const float pe = __builtin_amdgcn_exp2f(S[b][i] - mn); S[b][i] = pe; ps += pe; }
                lrun += ps;
                bf16x8 pk[NBLK][2];
#pragma unroll
                for (int b = 0; b < NBLK; ++b)
#pragma unroll
                    for (int s = 0; s < 2; ++s) { u32x4 w; w.x = pk2(S[b][8 * s], S[b][8 * s + 1]); w.y = pk2(S[b][8 * s + 2], S[b][8 * s + 3]); w.z = pk2(S[b][8 * s + 4], S[b][8 * s + 5]); w.w = pk2(S[b][8 * s + 6], S[b][8 * s + 7]);
                        pk[b][s] = __builtin_bit_cast(bf16x8, w); }
                const lds_u8* vp = Kt + vlane;
#pragma unroll
                for (int d = 0; d < NDB; ++d) {
#pragma unroll
                    for (int b = 0; b < NBLK; ++b)
#pragma unroll
                        for (int s = 0; s < 2; ++s) { const int off = ((ss + b) * 32 + 16 * s) * ROWB + d * 64;
                            const s16x4 lo = tr16(vp + off), hi = tr16(vp + off + 8 * ROWB);
                            const bf16x8 vf = __builtin_shufflevector(lo, hi, 0, 1, 2, 3, 4, 5, 6, 7);
                            O[d] = MFMA32(vf, pk[b][s], O[d]); }
                }
            }
        }
        if (t + 1 < nt) FL_STORE((s3 + 1) % 3, buf ^ 1);
        if (t + 4 < nt) FL_LOAD((s3 + 1) % 3, j + 4);
        __syncthreads();
        }
      }
    }
#undef FL_LOAD
#undef FL_STORE
    const float lt = lrun + __shfl_xor(lrun, 32); const float inv = 1.0f / lt;
#pragma unroll
    for (int d = 0; d < NDB; ++d)
#pragma unroll
        for (int k = 0; k < 4; k += 2) {
            unsigned ax = pk2(O[d][4 * k] * inv, O[d][4 * k + 1] * inv), ay = pk2(O[d][4 * k + 2] * inv, O[d][4 * k + 3] * inv);
            unsigned bx = pk2(O[d][4 * k + 4] * inv, O[d][4 * k + 5] * inv), by = pk2(O[d][4 * k + 6] * inv, O[d][4 * k + 7] * inv);
            { auto r0 = __builtin_amdgcn_permlane32_swap(ax, bx, false, false); ax = r0[0]; bx = r0[1]; }
            { auto r1 = __builtin_amdgcn_permlane32_swap(ay, by, false, false); ay = r1[0]; by = r1[1]; }
            if (store_ok) { u32x4 w; w.x = ax; w.y = ay; w.z = bx; w.w = by; *(u32x4*)(orow + dofs + d * 32 + 8 * k + 8 * h) = w; }
        }
}


DI void flash_abs_unit(lds_u8* lds, const bf16_t* qrow, const float* latA, const float* ropeA, const float* latN, const float* ropeN, int dofs, bf16_t* orow) {
    constexpr int ROWB = 592, TR = 32, TILEB = TR * ROWB, ND0 = 18, NDB = 4, NT = 129, KVLIM = 4112;
    const int tid = otid(), lane = tid & 63, r = lane & 31, h = lane >> 5;
    bf16x8 qf[ND0];
#pragma unroll
    for (int d0 = 0; d0 < ND0; ++d0) qf[d0] = *(const bf16x8*)(qrow + 16 * d0 + 8 * h);
    f32x16 O[NDB];
#pragma unroll
    for (int d = 0; d < NDB; ++d)
#pragma unroll
        for (int i = 0; i < 16; ++i) O[d][i] = 0.f;
    float mrun = -1e30f, lrun = 0.f;
    f32x4 kf[2][2][2], kr[2];
#define FA_LOAD(st, jt) do { const int kv0_ = (jt) * TR; \
    _Pragma("unroll") for (int i_ = 0; i_ < 2; ++i_) { const int c_ = tid + i_ * 512; const int row_ = c_ >> 5, cc_ = c_ & 31; int kv_ = kv0_ + row_; kv_ = kv_ < KVLIM ? kv_ : KVLIM - 1;   \
        const float* s_ = (kv_ < 4096 ? latA + (size_t)kv_ * 256 : latN + (size_t)(kv_ - 4096) * 256) + cc_ * 8; \
        kf[st][i_][0] = *(const f32x4*)s_; kf[st][i_][1] = *(const f32x4*)(s_ + 4); } \
    if (tid < 256) { const int row_ = tid >> 3, qq_ = tid & 7; int kv_ = kv0_ + row_; kv_ = kv_ < KVLIM ? kv_ : KVLIM - 1; \
        kr[st] = *(const f32x4*)((kv_ < 4096 ? ropeA + (size_t)kv_ * 32 : ropeN + (size_t)(kv_ - 4096) * 32) + qq_ * 4); } } while (0)
#define FA_STORE(st, buf) do { \
    _Pragma("unroll") for (int i_ = 0; i_ < 2; ++i_) { const int c_ = tid + i_ * 512; const int row_ = c_ >> 5, cc_ = c_ & 31; \
        u32x4 w_; w_.x = pk2(kf[st][i_][0].x, kf[st][i_][0].y); w_.y = pk2(kf[st][i_][0].z, kf[st][i_][0].w); w_.z = pk2(kf[st][i_][1].x, kf[st][i_][1].y); w_.w = pk2(kf[st][i_][1].z, kf[st][i_][1].w); \
        *(LAS u32x4*)(lds + (buf) * TILEB + row_ * ROWB + cc_ * 16) = w_; } \
    if (tid < 256) { const int row_ = tid >> 3, qq_ = tid & 7; u32x2 w2_; w2_.x = pk2(kr[st].x, kr[st].y); w2_.y = pk2(kr[st].z, kr[st].w); \
        *(LAS u32x2*)(lds + (buf) * TILEB + row_ * ROWB + 512 + qq_ * 8) = w2_; } } while (0)
#define FA_COMPUTE(j, buf) do { \
            const lds_u8* Kt = lds + (buf) * TILEB; \
            f32x16 S; \
            _Pragma("unroll") for (int i = 0; i < 16; ++i) S[i] = 0.f; \
            const lds_u8* kp = Kt + r * ROWB + h * 16; \
            _Pragma("unroll") for (int d0 = 0; d0 < ND0; ++d0) { const bf16x8 kfr = *(const LAS bf16x8*)(kp + d0 * 32); S = MFMA32(kfr, qf[d0], S); } \
            if ((j) * TR + TR > KVLIM) { \
                _Pragma("unroll") for (int i = 0; i < 16; ++i) if ((j) * TR + crow(i, h) >= KVLIM) S[i] = -1e30f; \
            } \
            float mt = S[0]; \
            _Pragma("unroll") for (int i = 1; i < 16; ++i) mt = fmaxf(mt, S[i]); \
            mt = halfmax(mt); \
            if (__any(mt > mrun)) { const float mn0 = fmaxf(mrun, mt); const float alpha = __builtin_amdgcn_exp2f(mrun - mn0); mrun = mn0; lrun *= alpha; \
                _Pragma("unroll") for (int d = 0; d < NDB; ++d) _Pragma("unroll") for (int i = 0; i < 16; ++i) O[d][i] *= alpha; } \
            const float mn = mrun; \
            float ps = 0.f; \
            _Pragma("unroll") for (int i = 0; i < 16; ++i) { const float pe = __builtin_amdgcn_exp2f(S[i] - mn); S[i] = pe; ps += pe; } \
            lrun += ps; \
            bf16x8 pk[2]; \
            _Pragma("unroll") for (int s = 0; s < 2; ++s) { u32x4 w; w.x = pk2(S[8 * s], S[8 * s + 1]); w.y = pk2(S[8 * s + 2], S[8 * s + 3]); w.z = pk2(S[8 * s + 4], S[8 * s + 5]); w.w = pk2(S[8 * s + 6], S[8 * s + 7]); \
                pk[s] = __builtin_bit_cast(bf16x8, w); } \
            const lds_u8* vp = Kt + vlane; \
            _Pragma("unroll") for (int d = 0; d < NDB; ++d) _Pragma("unroll") for (int s = 0; s < 2; ++s) { const int off = (16 * s) * ROWB + d * 64; \
                    const s16x4 lo = tr16(vp + off), hi = tr16(vp + off + 8 * ROWB); \
                    const bf16x8 vf = __builtin_shufflevector(lo, hi, 0, 1, 2, 3, 4, 5, 6, 7); \
                    O[d] = MFMA32(vf, pk[s], O[d]); } } while (0)
    const int vlane = (4 * h + ((lane & 15) >> 2)) * ROWB + (dofs + 16 * ((lane >> 4) & 1) + 4 * (lane & 3)) * 2;
    FA_LOAD(0, 0); FA_LOAD(1, 1); FA_STORE(0, 0); FA_LOAD(0, 2); __syncthreads();
    for (int j0 = 0; j0 < NT; j0 += 2) {
        { const int j = j0; FA_COMPUTE(j, 0); if (j + 1 < NT) FA_STORE(1, 1); if (j + 3 < NT) FA_LOAD(1, j + 3); __syncthreads(); }
        if (j0 + 1 < NT) { const int j = j0 + 1; FA_COMPUTE(j, 1); if (j + 1 < NT) FA_STORE(0, 0); if (j + 3 < NT) FA_LOAD(0, j + 3); __syncthreads(); }
    }
#undef FA_COMPUTE
#undef FA_LOAD
#undef FA_STORE
    const float lt = lrun + __shfl_xor(lrun, 32); const float inv = 1.0f / lt;
#pragma unroll
    for (int d = 0; d < NDB; ++d)
#pragma unroll
        for (int k = 0; k < 4; k += 2) {
            unsigned ax = pk2(O[d][4 * k] * inv, O[d][4 * k + 1] * inv), ay = pk2(O[d][4 * k + 2] * inv, O[d][4 * k + 3] * inv);
            unsigned bx = pk2(O[d][4 * k + 4] * inv, O[d][4 * k + 5] * inv), by = pk2(O[d][4 * k + 6] * inv, O[d][4 * k + 7] * inv);
            { auto r0 = __builtin_amdgcn_permlane32_swap(ax, bx, false, false); ax = r0[0]; bx = r0[1]; }
            { auto r1 = __builtin_amdgcn_permlane32_swap(ay, by, false, false); ay = r1[0]; by = r1[1]; }
            u32x4 w; w.x = ax; w.y = ay; w.z = bx; w.w = by; *(u32x4*)(orow + dofs + d * 32 + 8 * k + 8 * h) = w;
        }
}

template <class Epi>
DI void sgemm_phase(lds_u8* lds, const bf16_t* A, int lda, const bf16_t* Bt, int ldb, int K, int nN, int G, int bid, const Epi& E) {
    constexpr int PB = 144, TA = 64 * PB, TB = TA + 256 * PB;
    const int tid = otid(), lane = tid & 63, wave = __builtin_amdgcn_readfirstlane(tid >> 6), r = lane & 31, h = lane >> 5, wm = wave >> 2, wn = wave & 3;
    const int ntiles = 8 * nN, nk = K / 64;
    for (int t = G - 1 - bid; t < ntiles; t += G) {
        const int mi = t & 7, ni = t >> 3;
        const bf16_t* Ap = A + (size_t)(mi * 64 + (tid >> 3)) * lda + (tid & 7) * 8;
        const bf16_t* Bp = Bt + (size_t)(ni * 256 + (tid >> 3)) * ldb + (tid & 7) * 8;
        f32x16 acc0, acc1;
#pragma unroll
        for (int i = 0; i < 16; ++i) { acc0[i] = 0.f; acc1[i] = 0.f; }
        u32x4 ra[4], rb[4][4];
#define SG_LOAD(s, kt) do { ra[s] = *(const u32x4*)(Ap + (kt) * 64); _Pragma("unroll") for (int i_ = 0; i_ < 4; ++i_) rb[s][i_] = *(const u32x4*)(Bp + (size_t)i_ * 64 * ldb + (kt) * 64); } while (0)
#define SG_STORE(s, buf) do { lds_u8* b_ = lds + (buf) * TB + (tid >> 3) * PB + (tid & 7) * 16; *(LAS u32x4*)b_ = ra[s]; \
        _Pragma("unroll") for (int i_ = 0; i_ < 4; ++i_) *(LAS u32x4*)(b_ + TA + i_ * 64 * PB) = rb[s][i_]; } while (0)
#pragma unroll
        for (int s = 0; s < 4; ++s) if (s < nk) SG_LOAD(s, s);
        for (int kt0 = 0; kt0 < nk; kt0 += 4) {
#pragma unroll
            for (int s = 0; s < 4; ++s) {
                const int kt = kt0 + s;
                if (kt < nk) {
                    const int buf = s & 1;
                    SG_STORE(s, buf);
                    if (kt + 4 < nk) SG_LOAD(s, kt + 4);
                    __syncthreads();
                    const lds_u8* Aa = lds + buf * TB + (32 * wm + r) * PB + h * 16;
                    const lds_u8* Bb = lds + buf * TB + TA + (32 * wn + r) * PB + h * 16;
#pragma unroll
                    for (int ks = 0; ks < 4; ++ks) {
                        const bf16x8 af = *(const LAS bf16x8*)(Aa + ks * 32), w0 = *(const LAS bf16x8*)(Bb + ks * 32), w1 = *(const LAS bf16x8*)(Bb + 128 * PB + ks * 32);
                        acc0 = MFMA32(w0, af, acc0); acc1 = MFMA32(w1, af, acc1);
                    }
                }
            }
        }
        __syncthreads();
#undef SG_LOAD
#undef SG_STORE
        E(acc0, acc1, mi * 64 + 32 * wm + r, ni, wn, h);
    }
}
DI float silu_mul(float gt, float up) { return gt * __builtin_amdgcn_rcpf(1.0f + __builtin_amdgcn_exp2f(-gt * LOG2E)) * up; }
struct SEpiSwiGLU {
    bf16_t* O; const float* ssq;
    DI void operator()(const f32x16& a0, const f32x16& a1, int rl, int ni, int wn, int h) const {
        const int row = TP + rl; const float rs = srow_rstd(ssq, rl);
        bf16_t* o = O + (size_t)row * FF + ni * 128 + 32 * wn + 4 * h;
#pragma unroll
        for (int g = 0; g < 4; ++g) { u32x2 w; w.x = pk2(silu_mul(a0[4 * g] * rs, a1[4 * g] * rs), silu_mul(a0[4 * g + 1] * rs, a1[4 * g + 1] * rs));
            w.y = pk2(silu_mul(a0[4 * g + 2] * rs, a1[4 * g + 2] * rs), silu_mul(a0[4 * g + 3] * rs, a1[4 * g + 3] * rs)); *(u32x2*)(o + 8 * g) = w; }
    }
};
struct SEpiResid {
    const float* Xin; float* X; bf16_t* XB; float* ssqs; float scale;
    DI void operator()(const f32x16& a0, int rl, int ni, int wn, int h) const {
        const int row = TP + rl; float ss = 0.f;
        f32x4 xov[4];
#pragma unroll
        for (int g = 0; g < 4; ++g) xov[g] = *(const f32x4*)(Xin + (size_t)row * DM + ni * 128 + 32 * wn + 4 * h + 8 * g);
#pragma unroll
        for (int g = 0; g < 4; ++g) { const size_t off = (size_t)row * DM + ni * 128 + 32 * wn + 4 * h + 8 * g;
            const f32x4 av = (f32x4){a0[4 * g], a0[4 * g + 1], a0[4 * g + 2], a0[4 * g + 3]};
            const f32x4 xo = xov[g]; const f32x4 xn = xo + av * scale; *(f32x4*)(X + off) = xn;
            u32x2 w; w.x = pk2(xn.x, xn.y); w.y = pk2(xn.z, xn.w); *(u32x2*)(XB + off) = w; ss += (xn.x * xn.x + xn.y * xn.y) + (xn.z * xn.z + xn.w * xn.w); }
        ss += __shfl_xor(ss, 32);
        if (h == 0) ssqs[(size_t)rl * 32 + ni * 4 + wn] = ss;
    }
};
struct SEpiG3 {
    const float* ssqx; bf16_t* CQB; float* CKV; float* ssqq;
    DI void operator()(const f32x16& a0, const f32x16& a1, int rl, int ni, int wn, int h) const {
        const int row = TP + rl; const float rs = srow_rstd(ssqx, rl);
#pragma unroll
        for (int blk = 0; blk < 2; ++blk) {
            const int reg = ni * 2 + blk; const int c0 = reg * 128 + 32 * wn + 4 * h;
            f32x4 v[4]; float ss = 0.f;
#pragma unroll
            for (int g = 0; g < 4; ++g) { v[g] = (blk ? (f32x4){a1[4 * g], a1[4 * g + 1], a1[4 * g + 2], a1[4 * g + 3]} : (f32x4){a0[4 * g], a0[4 * g + 1], a0[4 * g + 2], a0[4 * g + 3]}) * rs;
                ss += (v[g].x * v[g].x + v[g].y * v[g].y) + (v[g].z * v[g].z + v[g].w * v[g].w); }
            if (reg < 3) {
                ss += __shfl_xor(ss, 32);
#pragma unroll
                for (int g = 0; g < 4; ++g) { u32x2 w; w.x = pk2(v[g].x, v[g].y); w.y = pk2(v[g].z, v[g].w); *(u32x2*)(CQB + (size_t)row * QL + c0 + 8 * g) = w; }
                if (h == 0) ssqq[(size_t)row * 16 + reg * 4 + wn] = ss;
            } else if (reg < 5) {
#pragma unroll
                for (int g = 0; g < 4; ++g) *(f32x4*)(CKV + (size_t)row * CKVW + (c0 - 384) + 8 * g) = v[g];
            } else if (wn == 0) {
#pragma unroll
                for (int g = 0; g < 4; ++g) *(f32x4*)(CKV + (size_t)row * CKVW + 256 + 4 * h + 8 * g) = v[g];
            }
        }
    }
};
struct SEpiQabs {
    const float* ssqq; const float* rope; bf16_t* O; float qscale;
    DI void operator()(const f32x16& a0, const f32x16& a1, int rl, int ni, int wn, int h) const {
        const float rs = row_rstd(ssqq, TP + rl, 3, 1.0f / QL) * qscale; const int pos = 4096 + (rl & 15);
#pragma unroll
        for (int blk = 0; blk < 2; ++blk) {
            const int g32 = ni * 8 + blk * 4 + wn; float v[16];
#pragma unroll
            for (int i = 0; i < 16; ++i) v[i] = (blk ? a1[i] : a0[i]) * rs;
            if (g32 % 9 == 8) {
#pragma unroll
                for (int i = 0; i < 8; ++i) { const int f = crow(i, h); const float cs = rope[(size_t)pos * 32 + f], sn = rope[(size_t)pos * 32 + 16 + f];
                    const float x1 = v[i], x2 = v[i + 8]; v[i] = x1 * cs - x2 * sn; v[i + 8] = x1 * sn + x2 * cs; }
            }
            bf16_t* o = O + (size_t)rl * 4608 + g32 * 32 + 4 * h;
#pragma unroll
            for (int g = 0; g < 4; ++g) { u32x2 w; w.x = pk2(v[4 * g], v[4 * g + 1]); w.y = pk2(v[4 * g + 2], v[4 * g + 3]); *(u32x2*)(o + 8 * g) = w; }
        }
    }
};
struct SEpiKV {
    const float* ssqx; bf16_t* KS; float* out;
    DI void operator()(const f32x16& a0, const f32x16& a1, int rl, int ni, int wn, int h) const {
        const float rs = srow_rstd(ssqx, rl); const int b = rl >> 4, s = rl & 15;
#pragma unroll
        for (int blk = 0; blk < 2; ++blk)
#pragma unroll
            for (int g = 0; g < 4; ++g) { const int c = blk * 128 + 32 * wn + 4 * h + 8 * g;
                const f32x4 v = (blk ? (f32x4){a1[4 * g], a1[4 * g + 1], a1[4 * g + 2], a1[4 * g + 3]} : (f32x4){a0[4 * g], a0[4 * g + 1], a0[4 * g + 2], a0[4 * g + 3]}) * rs;
                *(f32x4*)(out + (ni ? O_VS : O_KS) + (size_t)rl * 256 + c) = v;
                u32x2 w; w.x = pk2(v.x, v.y); w.y = pk2(v.z, v.w); *(u32x2*)(KS + ((size_t)b * 192 + 128 + s) * 512 + ni * 256 + c) = w; }
    }
};
struct SEpiRowScale {
    const float* ssqs; float oscale; bf16_t* O;
    DI void operator()(const f32x16& a0, int rl, int ni, int wn, int h) const {
        const int row = TP + rl; const float rs = srow_rstd(ssqs, rl) * oscale;
#pragma unroll
        for (int g = 0; g < 4; ++g) { u32x2 w; const int i = 4 * g; w.x = pk2(a0[i] * rs, a0[i + 1] * rs); w.y = pk2(a0[i + 2] * rs, a0[i + 3] * rs);
            *(u32x2*)(O + (size_t)row * DM + ni * 128 + 32 * wn + 4 * h + 8 * g) = w; }
    }
};
template <class Epi>
DI void sgemm64_phase(lds_u8* lds, const bf16_t* A, int lda, const bf16_t* Bt, int ldb, int K, int nN64, int G, int bid, const Epi& E) {
    constexpr int BKS = 256, PB = BKS * 2 + 16, TA = 32 * PB, TB = TA + 64 * PB, RED = 2 * TB;
    static_assert(RED + 32768 <= LDS_SLOT, "LDS");
    const int tid = otid(), lane = tid & 63, wave = __builtin_amdgcn_readfirstlane(tid >> 6), r = lane & 31, h = lane >> 5, cb = wave & 1, ks = wave >> 1;
    const int ntiles = 16 * nN64, nk = K / BKS;
    for (int t = G - 1 - bid; t < ntiles; t += G) {
        const int mi = t & 15, ni = t >> 4;
        const bf16_t* Ap = A + (size_t)(mi * 32 + (tid >> 5)) * lda + (tid & 31) * 8;
        const bf16_t* Bp = Bt + (size_t)(ni * 64 + (tid >> 5)) * ldb + (tid & 31) * 8;
        f32x16 acc;
#pragma unroll
        for (int i = 0; i < 16; ++i) acc[i] = 0.f;
        u32x4 ra[4][2], rb[4][4];
#define SG_LOAD(s, kt) do { _Pragma("unroll") for (int i_ = 0; i_ < 2; ++i_) ra[s][i_] = *(const u32x4*)(Ap + (size_t)i_ * 16 * lda + (kt) * BKS); \
        _Pragma("unroll") for (int i_ = 0; i_ < 4; ++i_) rb[s][i_] = *(const u32x4*)(Bp + (size_t)i_ * 16 * ldb + (kt) * BKS); } while (0)
#define SG_STORE(s, buf) do { lds_u8* b_ = lds + (buf) * TB + (tid >> 5) * PB + (tid & 31) * 16; \
        _Pragma("unroll") for (int i_ = 0; i_ < 2; ++i_) *(LAS u32x4*)(b_ + i_ * 16 * PB) = ra[s][i_]; \
        _Pragma("unroll") for (int i_ = 0; i_ < 4; ++i_) *(LAS u32x4*)(b_ + TA + i_ * 16 * PB) = rb[s][i_]; } while (0)
#pragma unroll
        for (int s = 0; s < 4; ++s) if (s < nk) SG_LOAD(s, s);
        for (int kt0 = 0; kt0 < nk; kt0 += 4) {
#pragma unroll
            for (int s = 0; s < 4; ++s) {
                const int kt = kt0 + s;
                if (kt < nk) {
                    const int buf = s & 1;
                    SG_STORE(s, buf);
                    if (kt + 4 < nk) SG_LOAD(s, kt + 4);
                    __syncthreads();
                    const lds_u8* Aa = lds + buf * TB + r * PB + ks * 128 + h * 16;
                    const lds_u8* Bb = lds + buf * TB + TA + (32 * cb + r) * PB + ks * 128 + h * 16;
#pragma unroll
                    for (int j = 0; j < 4; ++j) { const bf16x8 af = *(const LAS bf16x8*)(Aa + j * 32), w0 = *(const LAS bf16x8*)(Bb + j * 32); acc = MFMA32(w0, af, acc); }
                }
            }
        }
        __syncthreads();
#undef SG_LOAD
#undef SG_STORE
        LAS f32x4* red = (LAS f32x4*)(lds + RED) + ((cb * 4 + ks) * 64 + lane) * 4;
        if (ks != 0) {
#pragma unroll
            for (int q = 0; q < 4; ++q) red[q] = (f32x4){acc[4 * q], acc[4 * q + 1], acc[4 * q + 2], acc[4 * q + 3]};
        }
        __syncthreads();
        if (ks == 0) {
#pragma unroll
            for (int o = 1; o < 4; ++o)
#pragma unroll
                for (int q = 0; q < 4; ++q) { const f32x4 v = red[o * 64 * 4 + q]; acc[4 * q] += v.x; acc[4 * q + 1] += v.y; acc[4 * q + 2] += v.z; acc[4 * q + 3] += v.w; }
            E(acc, mi * 32 + r, ni >> 1, (ni & 1) * 2 + cb, h);
        }
        __syncthreads();
    }
}
template <class Epi>
DI void sgemm128_phase(lds_u8* lds, const bf16_t* A, int lda, const bf16_t* Bt, int ldb, int K, int nN  , int G, int bid, const Epi& E) {
    constexpr int PB = 144, TA = 64 * PB, TB = TA + 128 * PB;
    const int tid = otid(), lane = tid & 63, wave = __builtin_amdgcn_readfirstlane(tid >> 6), r = lane & 31, h = lane >> 5, wm = wave >> 2, wn = wave & 3;
    const int ntiles = 8 * nN, nk = K / 64;
    for (int t = G - 1 - bid; t < ntiles; t += G) {
        const int mi = t & 7, ni = t >> 3;
        const bf16_t* Ap = A + (size_t)(mi * 64 + (tid >> 3)) * lda + (tid & 7) * 8;
        const bf16_t* Bp = Bt + (size_t)(ni * 128 + (tid >> 3)) * ldb + (tid & 7) * 8;
        f32x16 acc0;
#pragma unroll
        for (int i = 0; i < 16; ++i) acc0[i] = 0.f;
        u32x4 ra[4], rb[4][2];
#define SG_LOAD(s, kt) do { ra[s] = *(const u32x4*)(Ap + (kt) * 64); _Pragma("unroll") for (int i_ = 0; i_ < 2; ++i_) rb[s][i_] = *(const u32x4*)(Bp + (size_t)i_ * 64 * ldb + (kt) * 64); } while (0)
#define SG_STORE(s, buf) do { lds_u8* b_ = lds + (buf) * TB + (tid >> 3) * PB + (tid & 7) * 16; *(LAS u32x4*)b_ = ra[s]; \
        _Pragma("unroll") for (int i_ = 0; i_ < 2; ++i_) *(LAS u32x4*)(b_ + TA + i_ * 64 * PB) = rb[s][i_]; } while (0)
#pragma unroll
        for (int s = 0; s < 4; ++s) if (s < nk) SG_LOAD(s, s);
        for (int kt0 = 0; kt0 < nk; kt0 += 4) {
#pragma unroll
            for (int s = 0; s < 4; ++s) {
                const int kt = kt0 + s;
                if (kt < nk) {
                    const int buf = s & 1;
                    SG_STORE(s, buf);
                    if (kt + 4 < nk) SG_LOAD(s, kt + 4);
                    __syncthreads();
                    const lds_u8* Aa = lds + buf * TB + (32 * wm + r) * PB + h * 16;
                    const lds_u8* Bb = lds + buf * TB + TA + (32 * wn + r) * PB + h * 16;
#pragma unroll
                    for (int ks = 0; ks < 4; ++ks) {
                        const bf16x8 af = *(const LAS bf16x8*)(Aa + ks * 32), w0 = *(const LAS bf16x8*)(Bb + ks * 32);
                        acc0 = MFMA32(w0, af, acc0);
                    }
                }
            }
        }
        __syncthreads();
#undef SG_LOAD
#undef SG_STORE
        E(acc0, mi * 64 + 32 * wm + r, ni, wn, h);
    }
}

DI void tr_item(const float* W, int ldw, const float* gain, bf16_t* WT, int ldo, int mode, int row_off, LAS float* scr, int kb, int nb, int lane) {
    const int k0 = 64 * kb, n0 = 32 * nb;
#pragma unroll 16
    for (int i = 0; i < 32; ++i) { const int kk = 2 * i + (lane >> 5); float v = W[(size_t)(k0 + kk) * ldw + n0 + (lane & 31)]; if (gain) v *= gain[k0 + kk]; scr[kk * 33 + (lane & 31)] = v; }
    asm volatile("s_waitcnt lgkmcnt(0)" ::: "memory");
    const int c = lane & 7;
#pragma unroll
    for (int j = 0; j < 4; ++j) { const int n = (lane >> 3) + 8 * j; const LAS float* s = scr + (8 * c) * 33 + n;
        u32x4 o; o.x = pk2(s[0 * 33], s[1 * 33]); o.y = pk2(s[2 * 33], s[3 * 33]); o.z = pk2(s[4 * 33], s[5 * 33]); o.w = pk2(s[6 * 33], s[7 * 33]);
        const int nn = n0 + n; const int orow = (mode == 0) ? row_off + nn : (mode <= 2) ? ((nn >> 7) * 256 + (nn & 127) + (mode == 2 ? 128 : 0)) : ((nn >> 6) * 128 + (nn & 63) + (mode == 4 ? 64 : 0));
        *(u32x4*)(WT + (size_t)orow * ldo + k0 + 8 * c) = o; }
    asm volatile("s_waitcnt lgkmcnt(0)" ::: "memory");
}
DI void tr64_item(const float* W, int ldw, const float* gain, bf16_t* WT, int ldo, int mode, LAS float* scr, int kb, int nb, int lane) {
    const int k0 = 64 * kb, n0 = 64 * nb;
    float v[64];
    const float* src = W + (size_t)k0 * ldw + n0 + lane;
#pragma unroll
    for (int i = 0; i < 64; ++i) v[i] = src[(size_t)i * ldw];
    if (gain) {
#pragma unroll
        for (int i = 0; i < 64; ++i) v[i] *= gain[k0 + i];
    }
#pragma unroll
    for (int i = 0; i < 64; ++i) scr[i * 65 + lane] = v[i];
    asm volatile("s_waitcnt lgkmcnt(0)" ::: "memory");
    const int c = lane & 7;
#pragma unroll
    for (int j = 0; j < 8; ++j) { const int n = (lane >> 3) + 8 * j; const LAS float* s = scr + (8 * c) * 65 + n;
        u32x4 o; o.x = pk2(s[0 * 65], s[1 * 65]); o.y = pk2(s[2 * 65], s[3 * 65]); o.z = pk2(s[4 * 65], s[5 * 65]); o.w = pk2(s[6 * 65], s[7 * 65]);
        const int nn = n0 + n; const int orow = (mode == 0) ? nn : (mode <= 2) ? ((nn >> 7) * 256 + (nn & 127) + (mode == 2 ? 128 : 0)) : ((nn >> 6) * 128 + (nn & 63) + (mode == 4 ? 64 : 0));
        *(u32x4*)(WT + (size_t)orow * ldo + k0 + 8 * c) = o; }
    asm volatile("s_waitcnt lgkmcnt(0)" ::: "memory");
}
DI void tr_matrix(const float* W, int K, int N, const float* gain, bf16_t* WT, int ldo, int mode, int row_off, LAS float* scr, int gw, int NGW, int lane) {
    const int nblk = N / 32, nitems = (K / 64) * nblk;
    for (int it = gw; it < nitems; it += NGW) tr_item(W, N, gain, WT, ldo, mode, row_off, scr, it / nblk, it % nblk, lane);
}


#define XB_TMO      128
#define XB_XCNT(j)  (256  + 64 * (j))
#define XB_XSUB(j)  (1280 + 64 * (j))
#define XB_XGEN(j)  (2304 + 64 * (j))
#define XB_TOP      3328
#define XB_TOPGEN   3392
#define XB_SPIN_CAP (1u << 22)
DI unsigned xb_ld(unsigned* p)              { return __hip_atomic_load(p, __ATOMIC_RELAXED, __HIP_MEMORY_SCOPE_AGENT); }
DI unsigned xb_add(unsigned* p, unsigned v) { return __hip_atomic_fetch_add(p, v, __ATOMIC_RELAXED, __HIP_MEMORY_SCOPE_AGENT); }
DI unsigned xb_xcc_id() { return (unsigned)__builtin_amdgcn_s_getreg((3 << 11) | 20) & 0xFu; }
#define XB_SPIN(cond, bar) do { unsigned _sp = 0; while (cond) { __builtin_amdgcn_s_sleep(1); \
    if ((++_sp & 255u) == 0u) { if (xb_ld(&(bar)[XB_TMO])) break; if (_sp > XB_SPIN_CAP) { atomicAdd(&(bar)[XB_TMO], 1u); break; } } } } while (0)
struct XcdBarrier { unsigned* bar; unsigned x; volatile LAS unsigned* st; };
DI XcdBarrier xcd_barrier_post(unsigned* bar, volatile LAS unsigned* st) {
    XcdBarrier b; b.bar = bar; b.x = xb_xcc_id(); b.st = st;
    if (threadIdx.x == 0) (void)xb_add(&bar[XB_XCNT(b.x)], 1u);
    return b;
}
DI void xcd_barrier_complete(unsigned* bar, unsigned x, unsigned& nloc, unsigned& nx) {
    const unsigned G = gridDim.x * gridDim.y * gridDim.z;
    unsigned sum, cnt, mine, sp = 0u;
    for (;;) {
        sum = 0u; cnt = 0u; mine = 0u;
#pragma unroll
        for (unsigned j = 0; j < 16; ++j) { const unsigned c = xb_ld(&bar[XB_XCNT(j)]); sum += c; cnt += (c > 0u) ? 1u : 0u; mine = (j == x) ? c : mine; }
        if (sum == G) break;
        __builtin_amdgcn_s_sleep(1);
        if ((++sp & 255u) == 0u) { if (xb_ld(&bar[XB_TMO])) break; if (sp > XB_SPIN_CAP) { atomicAdd(&bar[XB_TMO], 1u); break; } }
    }
    nloc = mine > 0u ? mine : 1u; nx = cnt > 0u ? cnt : 1u;
}
DI void xcd_barrier(const XcdBarrier& b) {
    asm volatile("s_waitcnt vmcnt(0)" ::: "memory");
    __syncthreads();
    if (threadIdx.x == 0) {
        unsigned* bar = b.bar;
        __builtin_amdgcn_s_waitcnt(0);
        unsigned nloc = b.st[0], nx = b.st[1];
        if (nloc == 0u) { xcd_barrier_complete(bar, b.x, nloc, nx); b.st[0] = nloc; b.st[1] = nx; }
        const unsigned old = xb_add(&bar[XB_XSUB(b.x)], 1u);
        const unsigned gen = old / nloc;
        if (old + 1u == (gen + 1u) * nloc) {
            __builtin_amdgcn_fence(__ATOMIC_RELEASE, "agent");
            asm volatile("s_waitcnt vmcnt(0)" ::: "memory");
            const unsigned og = xb_add(&bar[XB_TOP], 1u);
            const unsigned tg = og / nx;
            if (og + 1u == (tg + 1u) * nx) xb_add(&bar[XB_TOPGEN], 1u);
            else XB_SPIN(xb_ld(&bar[XB_TOPGEN]) == tg, bar);
            __builtin_amdgcn_fence(__ATOMIC_ACQUIRE, "agent");
            xb_add(&bar[XB_XGEN(b.x)], 1u);
            asm volatile("s_waitcnt vmcnt(0)" ::: "memory");
        } else {
            XB_SPIN(xb_ld(&bar[XB_XGEN(b.x)]) == gen, bar);
            __builtin_amdgcn_fence(__ATOMIC_ACQUIRE, "agent");
            asm volatile("s_waitcnt vmcnt(0)" ::: "memory");
        }
    }
    __syncthreads();
}

struct Params {
    const float* in[30];
    float* out;
    unsigned char* ws;
    float inv_freq[16];
};

#define WSP(T_, off_) ((T_*)(p.ws + (off_)))
#define P_WGU WSP(bf16_t, WS_WGU)
#define P_WD WSP(bf16_t, WS_WD)
#define P_W3 WSP(bf16_t, WS_W3)
#define P_WUQT WSP(bf16_t, WS_WUQT)
#define P_WABST WSP(bf16_t, WS_WABST)
#define P_W5T WSP(bf16_t, WS_WUKT)
#define P_WOT WSP(bf16_t, WS_WOT)
#define P_WOVT WSP(bf16_t, WS_WOVT)
#define P_WKVT WSP(bf16_t, WS_WKVT)
#define P_WQST WSP(bf16_t, WS_WQST)
#define P_WOST WSP(bf16_t, WS_WOST)
#define P_ROPE WSP(float, WS_ROPE)
#define P_BT WSP(float, WS_BT)
#define P_XB WSP(bf16_t, WS_XB)
#define P_SSQX WSP(float, WS_SSQX)
#define P_SSQQ WSP(float, WS_SSQQ)
#define P_SSQL WSP(float, WS_SSQL)
#define P_SSQS WSP(float, WS_SSQS)
#define P_ACT WSP(bf16_t, WS_ACT)
#define P_QB WSP(bf16_t, WS_QB)
#define P_QS WSP(bf16_t, WS_QS)
#define P_CQB WSP(bf16_t, WS_CQB)
#define P_CKV WSP(float, WS_CKV)
#define P_LATB WSP(bf16_t, WS_LATB)
#define P_OB WSP(bf16_t, WS_OB)
#define P_QA WSP(bf16_t, WS_QA)
#define P_KNV WSP(bf16_t, WS_KNV)
#define P_KRB WSP(bf16_t, WS_KRB)
#define P_OA WSP(bf16_t, WS_OA)
#define P_KVSB WSP(bf16_t, WS_KVSB)
#define P_KS WSP(bf16_t, WS_KS)
#define P_KC WSP(bf16_t, WS_KC)
#define P_CTL WSP(unsigned, WS_CTL)

__global__ void __launch_bounds__(NTHREADS) yoco_fwd(Params p) {
    extern __shared__ __attribute__((aligned(16))) unsigned char lds_raw[];
    cg::grid_group grid = cg::this_grid();
    lds_u8* lds = (lds_u8*)lds_raw;
    const int G = gridDim.x, bid = blockIdx.x, NGW = G * NWAVES;
#define PHASE_IDS const int tid = otid(), lane = tid & 63, wave = __builtin_amdgcn_readfirstlane(tid >> 6), gw = bid * NWAVES + wave; (void)lane; (void)gw
    float* X = p.out;
    LAS int* slot = (LAS int*)(lds + LDS_SLOT);
    volatile LAS unsigned* bst = (volatile LAS unsigned*)(lds + LDS_SLOT + 16);
    if (threadIdx.x == 0) { bst[0] = 0u; bst[1] = 0u; }
    __syncthreads();
    const XcdBarrier xbar = xcd_barrier_post(P_CTL + 4096, bst);
#define GSYNC() xcd_barrier(xbar)

    {
        PHASE_IDS;
        LAS float* scr = (LAS float*)(lds + wave * 16640);
        {
            const int sgw = gw, SNGW = NGW;
            for (int row0 = sgw * 2; row0 < TT; row0 += SNGW * 2) {
                f32x4 v[2][4];
#pragma unroll
                for (int q = 0; q < 2; ++q) { const int row = row0 + q; const float* src = row < TP ? p.in[0] + (size_t)row * DM : p.in[1] + (size_t)(row - TP) * DM;
#pragma unroll
                    for (int j = 0; j < 4; ++j) v[q][j] = *(const f32x4*)(src + j * 256 + lane * 4); }
#pragma unroll
                for (int q = 0; q < 2; ++q) { const int row = row0 + q; float ss = 0.f;
#pragma unroll
                    for (int j = 0; j < 4; ++j) { const f32x4 t = v[q][j]; u32x2 w; w.x = pk2(t.x, t.y); w.y = pk2(t.z, t.w); *(u32x2*)(P_XB + (size_t)row * DM + j * 256 + lane * 4) = w; ss += (t.x * t.x + t.y * t.y) + (t.z * t.z + t.w * t.w); }
                    ss = wave_sum(ss);
                    if (row < TP) { if (lane < 16) P_SSQX[(size_t)row * 16 + lane] = (lane == 0) ? ss : 0.f; }
                    else if (lane < 32) P_SSQS[(size_t)(row - TP) * 32 + lane] = (lane == 0) ? ss : 0.f; }
            }
            {
                constexpr int I_F = 704, I_DQ = 96, I_UQ = 144, I_UK = 64, I_O = 256, I_KV = 128;
                constexpr int NIT = 12 * I_F + I_DQ + I_UQ + 2 * I_UK + 3 * I_O + I_KV;
                for (int it = sgw; it < NIT; it += SNGW) {
                    int rI = it;
                    const float* W; const float* gain = nullptr; bf16_t* WT; int N_, ldo, mode = 0;
                    if (rI < 12 * I_F) { const int m = rI / I_F; rI -= m * I_F; const int l = m / 6, t = m % 6, f = 2 * l + (t >= 3 ? 1 : 0), tt = t % 3;
                        if (tt == 2) { W = p.in[t == 2 ? 9 : 14] + (size_t)l * FF * DM; N_ = DM; WT = P_WD + (size_t)f * DM * FF; ldo = FF; }
                        else { W = p.in[(t >= 3 ? 12 : 7) + tt] + (size_t)l * DM * FF; N_ = FF; gain = p.in[t >= 3 ? 11 : 6] + l * DM; WT = P_WGU + (size_t)f * FF2 * DM; ldo = DM; mode = 1 + tt; }
                    } else { rI -= 12 * I_F;
                        if (rI < I_DQ) { W = p.in[15]; N_ = QL; gain = p.in[10]; WT = P_W3; ldo = DM; }
                        else if ((rI -= I_DQ) < I_UQ) { W = p.in[17]; N_ = 1536; gain = p.in[16]; WT = P_WUQT; ldo = QL; }
                        else if ((rI -= I_UQ) < I_UK) { W = p.in[20]; N_ = 1024; gain = p.in[19]; WT = P_W5T; ldo = KVL; mode = 3; }
                        else if ((rI -= I_UK) < I_UK) { W = p.in[21]; N_ = 1024; gain = p.in[19]; WT = P_W5T; ldo = KVL; mode = 4; }
                        else if ((rI -= I_UK) < I_O) { W = p.in[22]; N_ = DM; WT = P_WOT; ldo = DM; }
                        else if ((rI -= I_O) < I_KV) { W = p.in[24]; N_ = 512; gain = p.in[23]; WT = P_WKVT; ldo = DM; }
                        else if ((rI -= I_KV) < I_O) { W = p.in[25]; N_ = DM; gain = p.in[10] + DM; WT = P_WQST; ldo = DM; }
                        else { rI -= I_O; W = p.in[27]; N_ = DM; WT = P_WOST; ldo = DM; }
                    }
                    const int nblk = N_ / 64;
                    tr64_item(W, N_, gain, WT, ldo, mode, scr, rI / nblk, rI % nblk, lane);
                }
            }
            tr_matrix(p.in[18], DM, CKVW, p.in[10], P_W3, DM, 0, 384, scr, sgw, SNGW, lane);
            for (int i = sgw * 64 + lane; i < 96 * DM / 8; i += SNGW * 64) *(u32x4*)(P_W3 + (size_t)672 * DM + (size_t)i * 8) = (u32x4){0u, 0u, 0u, 0u};
            for (int rw = sgw; rw < 32 * 128; rw += SNGW) {
                const int b = rw >> 7, kk = rw & 127; bf16_t* dst = P_KS + ((size_t)b * 192 + kk) * 512;
                const f32x4 v = *(const f32x4*)(p.in[4] + (size_t)rw * 256 + lane * 4); u32x2 w; w.x = pk2(v.x, v.y); w.y = pk2(v.z, v.w); *(u32x2*)(dst + lane * 4) = w;
                const f32x4 q = *(const f32x4*)(p.in[5] + (size_t)rw * 256 + lane * 4); u32x2 w2; w2.x = pk2(q.x, q.y); w2.y = pk2(q.z, q.w); *(u32x2*)(dst + 256 + lane * 4) = w2;
            }
        }
        {
            const int cgw = gw, CNGW = NGW;
            for (int i = cgw * 64 + lane; i < KCL * 16; i += CNGW * 64) { const int pos = i >> 4, f = i & 15; const float ang = (float)pos * p.inv_freq[f];
                P_ROPE[(size_t)pos * 32 + f] = cosf(ang); P_ROPE[(size_t)pos * 32 + 16 + f] = sinf(ang); }
            for (int i = cgw * 64 + lane; i < 16 * 256; i += CNGW * 64) { const int hh = i >> 8, idx = i & 255; const int rel = idx - 191; const int n = rel < 0 ? -rel : rel;
                const float nf = (float)(n > 1 ? n : 1);
                int large = 8 + (int)(logf(nf / 8.0f) / 2.7725887298583984f * 8.0f); large = large < 15 ? large : 15;
                const int bucket = (rel > 0 ? 16 : 0) + (n < 8 ? n : large);
                P_BT[i] = p.in[28][bucket * 16 + hh] * LOG2E; }
            for (int it = cgw; it < 16 * 16 * 8; it += CNGW) {
                const int hh = it >> 7, nb = (it >> 3) & 15, cg_ = it & 7; const int n = nb * 64 + lane;
#pragma unroll
                for (int q = 0; q < 8; ++q) { const int idx = q * 64 + lane, cc = idx >> 4, j4 = idx & 15;
                    *(LAS f32x4*)(scr + cc * 64 + j4 * 4) = *(const f32x4*)(p.in[21] + (size_t)(cg_ * 32 + cc) * 1024 + hh * 64 + j4 * 4); }
                float bw[64];
                const float* bo = p.in[22] + (size_t)(hh * 64) * 1024 + n;
#pragma unroll
                for (int j = 0; j < 64; ++j) bw[j] = bo[(size_t)j * 1024];
                asm volatile("s_waitcnt lgkmcnt(0)" ::: "memory");
                for (int c8 = 0; c8 < 4; ++c8) {
                    float s[8];
#pragma unroll
                    for (int cc = 0; cc < 8; ++cc) { const LAS f32x4* av = (const LAS f32x4*)(scr + (c8 * 8 + cc) * 64); float acc = 0.f;
#pragma unroll
                        for (int j = 0; j < 16; ++j) { const f32x4 a4 = av[j]; acc += (bw[4 * j] * a4.x + bw[4 * j + 1] * a4.y) + (bw[4 * j + 2] * a4.z + bw[4 * j + 3] * a4.w); }
                        s[cc] = acc; }
                    u32x4 o; o.x = pk2(s[0], s[1]); o.y = pk2(s[2], s[3]); o.z = pk2(s[4], s[5]); o.w = pk2(s[6], s[7]);
                    *(u32x4*)(P_WOVT + (size_t)n * 4096 + hh * 256 + cg_ * 32 + c8 * 8) = o;
                }
                asm volatile("s_waitcnt lgkmcnt(0)" ::: "memory");
            }
            for (int it = cgw; it < 16 * 6 * 33; it += CNGW) {
                const int hh = it / 198, rem = it % 198, kb = rem / 33, cq = rem % 33; const int k = kb * 64 + lane;
                const float* aq = p.in[17] + (size_t)k * 1536 + hh * 96; const float gq = p.in[16][k];
                if (cq < 32) {
                    float a[64];
#pragma unroll
                    for (int j = 0; j < 16; ++j) { const f32x4 t = *(const f32x4*)(aq + 4 * j); a[4 * j] = t.x; a[4 * j + 1] = t.y; a[4 * j + 2] = t.z; a[4 * j + 3] = t.w; }
#pragma unroll
                    for (int cc = 0; cc < 8; ++cc) { const int c = cq * 8 + cc; const float* bk = p.in[20] + (size_t)c * 1024 + hh * 64; float s = 0.f;
#pragma unroll
                        for (int j = 0; j < 64; ++j) s += a[j] * bk[j];
                        P_WABST[(size_t)(hh * 288 + c) * QL + k] = f2bf(s * gq); }
                } else {
                    for (int rr = 0; rr < 32; ++rr) P_WABST[(size_t)(hh * 288 + 256 + rr) * QL + k] = f2bf(aq[64 + rr] * gq);
                }
            }
        }
    }
    grid.sync();

    pg8::StaticOrder S;
#define GEMM_UP(f) do { { pg8::Gemm g{P_XB, P_WGU + (size_t)(f) * FF2 * DM, DM, DM, DM}; S.init(TT, FF2, G, bid); pg8::EpiSwiGLU E{P_ACT, P_SSQX, P_SSQS}; pg8::gemm_phase(lds, g, S, E); } } while (0)
#define GEMM_DOWN(f) do { { pg8::Gemm g{P_ACT, P_WD + (size_t)(f) * DM * FF, FF, FF, FF}; S.init(TP, DM, G, bid); pg8::EpiResid E{(f) == 0 ? p.in[0] : X, X, P_XB, P_SSQX, 0.5f, 0}; pg8::gemm_phase(lds, g, S, E); } \
    { SEpiResid E2{(f) == 0 ? p.in[1] - (size_t)TP * DM : X, X, P_XB, P_SSQS, 0.5f}; sgemm64_phase(lds, P_ACT + (size_t)TP * FF, FF, P_WD + (size_t)(f) * DM * FF, FF, FF, DM / 64, G, bid, E2); } } while (0)

    GEMM_UP(0); GSYNC();
    GEMM_DOWN(0); GSYNC();
    { pg8::Gemm g{P_XB, P_W3, DM, DM, DM}; S.init(TP, 768, G, bid); pg8::EpiG3 E{P_SSQX, P_CQB, P_CKV, P_LATB, P_SSQQ, P_SSQL}; pg8::gemm_phase(lds, g, S, E); }
    { SEpiG3 E2{P_SSQS, P_CQB, P_CKV, P_SSQQ}; sgemm_phase(lds, P_XB + (size_t)TP * DM, DM, P_W3, DM, DM, 3, G, bid, E2); }
    GSYNC();
    {
        { PHASE_IDS;
        for (int row0 = gw * 2; row0 < TT; row0 += NGW * 2) {
            f32x4 vv[2]; float x1v[2], x2v[2];
#pragma unroll
            for (int q = 0; q < 2; ++q) { const float* ck = P_CKV + (size_t)(row0 + q) * CKVW; vv[q] = *(const f32x4*)(ck + lane * 4); x1v[q] = ck[256 + (lane & 15)]; x2v[q] = ck[272 + (lane & 15)]; }
#pragma unroll
            for (int q = 0; q < 2; ++q) {
            const int row = row0 + q; const f32x4 v = vv[q];
            const float ss = wave_sum((v.x * v.x + v.y * v.y) + (v.z * v.z + v.w * v.w)); const float rs = rsqrtf(ss * (1.0f / KVL) + RMS_EPS);
            const f32x4 gn = *(const f32x4*)(p.in[19] + lane * 4); const f32x4 o = v * rs * gn;
            const bool smp = row >= TP; const int sr = row - TP;
            *(f32x4*)(p.out + (smp ? O_LATS + (size_t)sr * 256 : O_LATP + (size_t)row * 256) + lane * 4) = o;
            const int pos = smp ? 4096 + (sr & 15) : (row & 4095);
            float kr = 0.f;
            if (lane < 32) { const int f = lane & 15; const float x1 = x1v[q], x2 = x2v[q];
                const float cs = P_ROPE[(size_t)pos * 32 + f], sn = P_ROPE[(size_t)pos * 32 + 16 + f];
                kr = lane < 16 ? x1 * cs - x2 * sn : x1 * sn + x2 * cs;
                p.out[(smp ? O_ROPES + (size_t)sr * 32 : O_ROPEP + (size_t)row * 32) + lane] = kr; }
            if (!smp && lane < 32) P_KRB[(size_t)row * 32 + lane] = f2bf(kr);
            }
        } }
        const float qscale = 0.10206207261596577f * LOG2E;
        { pg8::Gemm g{P_CQB, P_WUQT, QL, QL, QL}; S.init(TP, 1536, G, bid); pg8::EpiQ E{P_SSQQ, P_ROPE, P_QB, 1536, 0, 0, 3, 2, qscale}; pg8::gemm_phase(lds, g, S, E); }
        { SEpiQabs E2{P_SSQQ, P_ROPE, P_QA, qscale}; sgemm_phase(lds, P_CQB + (size_t)TP * QL, QL, P_WABST, QL, QL, 18, G, bid, E2); }
        { pg8::Gemm g{P_LATB, P_W5T, KVL, KVL, KVL}; S.init(TP, 2048, G, bid); pg8::EpiRowScale E{P_SSQL, 2, 1.0f / KVL, 1.0f, P_KNV, 2048}; pg8::gemm_phase(lds, g, S, E); }
    }
    GSYNC();
    {
        PHASE_IDS;
        for (;;) {
            __syncthreads(); if (tid == 0) *slot = (int)atomicAdd(P_CTL + 0, 1u); __syncthreads();
            const int u = *slot; if (u >= 64 + 1024) break;
            const int r = lane & 31;
            if (u < 64) {
                const int b = u >> 1, hf = u & 1, qb = wave & 3, dh = wave >> 2; const int head = hf * 8 + qb * 2 + (r >> 4), s = r & 15;
                flash_abs_unit(lds, P_QA + (size_t)(b * 16 + s) * 4608 + head * 288, p.in[2] + (size_t)b * 4096 * 256, p.in[3] + (size_t)b * 4096 * 32,
                    p.out + O_LATS + (size_t)b * 16 * 256, p.out + O_ROPES + (size_t)b * 16 * 32, dh * 128, P_OA + (size_t)(b * 16 + s) * 4096 + head * 256);
            } else {
                const int u2 = u - 64, i = 15 - (u2 >> 6), bh = u2 & 63, b = bh >> 4, hh = bh & 15; const int q = i * 256 + wave * 32 + r;
                flash_unit<96, 160, 4, 64, 64, 2, 2, false>(lds, P_QB + (size_t)(b * SEQ + q) * 1536 + hh * 96, P_KNV + (size_t)b * SEQ * 2048 + hh * 128, 2048, 16, P_KRB + (size_t)b * SEQ * 32, 32,
                    0, 0, 4 * (i + 1), 4 * i + (wave >> 1) + 1, 1 << 30, -1e30f, 0.f, (const LAS float*)lds, 0,
                    P_OB + (size_t)(b * SEQ + q) * DM + hh * 64, true);
            }
        }
    }
    GSYNC();
    { pg8::Gemm g{P_OB, P_WOT, DM, DM, DM}; S.init(TP, DM, G, bid); pg8::EpiResid E{X, X, P_XB, P_SSQX, 1.0f, 0}; pg8::gemm_phase(lds, g, S, E); }
    { SEpiResid E2{X, X, P_XB, P_SSQS, 1.0f}; sgemm64_phase(lds, P_OA, 4096, P_WOVT, 4096, 4096, 16, G, bid, E2); }
    GSYNC();
    GEMM_UP(1); GSYNC();
    GEMM_DOWN(1); GSYNC();
    { pg8::Gemm g{P_XB, P_WKVT, DM, DM, DM}; S.init(TT, 512, G, G - 1 - bid); pg8::EpiKV E{P_SSQX, P_KVSB, P_KS, p.out, P_SSQS}; pg8::gemm_phase(lds, g, S, E); }
    GEMM_UP(2); GSYNC();
    GEMM_DOWN(2); GSYNC();
    { pg8::Gemm g{P_XB, P_WQST, DM, DM, DM}; S.init(TP, DM, G, bid); pg8::EpiRowScale E{P_SSQX, 4, 1.0f / DM, 0.125f * LOG2E, P_QS, DM}; pg8::gemm_phase(lds, g, S, E); }
    { SEpiRowScale E2{P_SSQS, 0.125f * LOG2E, P_QS}; sgemm64_phase(lds, P_XB + (size_t)TP * DM, DM, P_WQST, DM, DM, 16, G, bid, E2); }
    GSYNC();
    {
        PHASE_IDS;
        LAS float* btab = (LAS float*)(lds + 40960);
        int g4_loaded = -1;
        for (int u = bid; u < 1024 + 128; u += G) {
            const int r = lane & 31;
            int b, g4, c; bool smp;
            if (u < 1024) { smp = false; b = u >> 8; c = (u >> 2) & 63; g4 = u & 3; } else { smp = true; const int v = u - 1024; b = v >> 2; g4 = v & 3; c = 64; }
            if (g4 != g4_loaded) { __syncthreads(); for (int i = tid; i < 1024; i += NTHREADS) btab[i] = P_BT[(g4 * 4 + (i >> 8)) * 256 + (i & 255)]; g4_loaded = g4; }
            const int hh = g4 * 4 + (wave >> 1);
            const float sink = p.in[26][hh] * LOG2E;
            if (!smp) {
                const int qi = (wave & 1) * 32 + r; const size_t qrow = (size_t)b * SEQ + c * 64 + qi; const int j0 = c >= 2 ? 0 : 2 - c;
                const bf16_t* kv = P_KVSB + ((long)b * SEQ + (c - 2) * 64) * 512 + g4 * 64;
                flash_unit<64, 128, 4, 0, 64, 2, 2, true>(lds, P_QS + qrow * DM + hh * 64, kv, 512, 8, kv + 256, 512,
                    0, j0, 3, 3, 1 << 30, sink, (lane >> 5) == 0 ? 1.f : 0.f,
                    btab + (wave >> 1) * 256, 63 - qi, P_OB + qrow * DM + hh * 64, true);
            } else {
                const int qi = r & 15; const size_t qrow = (size_t)TP + b * 16 + qi;
                const bf16_t* kv = P_KS + (size_t)b * 192 * 512 + g4 * 64;
                flash_unit<64, 128, 4, 0, 64, 2, 2, true>(lds, P_QS + qrow * DM + hh * 64, kv, 512, 8, kv + 256, 512,
                    0, 0, 3, (wave & 1) ? 0 : 3, 144, sink, (lane >> 5) == 0 ? 1.f : 0.f,
                    btab + (wave >> 1) * 256, 63 - qi, P_OB + qrow * DM + hh * 64, (wave & 1) == 0 && r < 16);
            }
        }
    }
    GSYNC();
    { pg8::Gemm g{P_OB, P_WOST, DM, DM, DM}; S.init(TP, DM, G, bid); pg8::EpiResid E{X, X, P_XB, P_SSQX, 1.0f, 0}; pg8::gemm_phase(lds, g, S, E); }
    { SEpiResid E2{X, X, P_XB, P_SSQS, 1.0f}; sgemm64_phase(lds, P_OB + (size_t)TP * DM, DM, P_WOST, DM, DM, 16, G, bid, E2); }
    GSYNC();
    GEMM_UP(3); GSYNC();
    GEMM_DOWN(3); GSYNC();
    { PHASE_IDS;
    for (int row0 = gw * 2; row0 < TT; row0 += NGW * 2) {
        f32x4 v[2][4];
#pragma unroll
        for (int q = 0; q < 2; ++q)
#pragma unroll
            for (int j = 0; j < 4; ++j) v[q][j] = *(const f32x4*)(X + (size_t)(row0 + q) * DM + j * 256 + lane * 4);
#pragma unroll
        for (int q = 0; q < 2; ++q) { float ss = 0.f;
#pragma unroll
            for (int j = 0; j < 4; ++j) ss += (v[q][j].x * v[q][j].x + v[q][j].y * v[q][j].y) + (v[q][j].z * v[q][j].z + v[q][j].w * v[q][j].w);
            const float rs = rsqrtf(wave_sum(ss) * (1.0f / DM) + RMS_EPS);
#pragma unroll
            for (int j = 0; j < 4; ++j) { const f32x4 gn = *(const f32x4*)(p.in[29] + j * 256 + lane * 4); *(f32x4*)(X + (size_t)(row0 + q) * DM + j * 256 + lane * 4) = v[q][j] * rs * gn; } }
    } }
}

extern "C" void kernel_launch(void* const* d_in, const int* in_sizes, int n_in, void* d_out, int out_size, void* d_ws, size_t ws_size, hipStream_t stream) {
    static int grid = 0;
    if (grid == 0) {
        if (n_in != 30 || ws_size < WS_END) { fprintf(stderr, "kernel_launch: n_in %d ws %zu (need %zu)\n", n_in, ws_size, (size_t)WS_END); grid = -1; return; }
        int dev = 0, cus = 0, per_cu = 0;
        hipGetDevice(&dev);
        hipDeviceGetAttribute(&cus, hipDeviceAttributeMultiprocessorCount, dev);
        hipFuncSetAttribute((const void*)yoco_fwd, hipFuncAttributeMaxDynamicSharedMemorySize, LDS_BYTES);
        hipOccupancyMaxActiveBlocksPerMultiprocessor(&per_cu, (const void*)yoco_fwd, NTHREADS, LDS_BYTES);
        if (per_cu < 1) per_cu = 1;
        grid = cus;
        (void)hipGetLastError();
    }
    if (grid < 0) return;
    (void)hipMemsetAsync((char*)d_ws + WS_CTL, 0, CTL_BYTES, stream);
    Params p{};
    for (int i = 0; i < 30; ++i) p.in[i] = (const float*)d_in[i];
    p.out = (float*)d_out; p.ws = (unsigned char*)d_ws;
    for (int i = 0; i < 16; ++i) p.inv_freq[i] = (float)pow(10000.0, -(double)(2 * i) / 32.0);
    void* args[] = {&p};
    hipError_t e = hipLaunchCooperativeKernel((const void*)yoco_fwd, dim3(grid), dim3(NTHREADS), args, LDS_BYTES, stream);
    if (e != hipSuccess) fprintf(stderr, "cooperative launch failed: %s (grid %d)\n", hipGetErrorString(e), grid);
}
```

```cpp
#include <hip/hip_runtime.h>
#include <hip/hip_cooperative_groups.h>
#include <cstdio>
#include <cstdint>
#include <cmath>
namespace cg = cooperative_groups;

#define DI __device__ __forceinline__
#define LAS __attribute__((address_space(3)))
typedef unsigned short bf16_t;
typedef short bf16x8 __attribute__((ext_vector_type(8)));
typedef short s16x4 __attribute__((ext_vector_type(4)));
typedef float f32x4 __attribute__((ext_vector_type(4)));
typedef float f32x16 __attribute__((ext_vector_type(16)));
typedef unsigned u32x4 __attribute__((ext_vector_type(4)));
typedef unsigned u32x2 __attribute__((ext_vector_type(2)));
typedef LAS unsigned char lds_u8;

constexpr int DM = 1024, TP = 16384, TS = 512, TT = TP + TS, SEQ = 4096;
constexpr int FF = 2816, FF2 = 5632;
constexpr int QL = 384, KVL = 256, CKVW = 288, QD = 96;
constexpr int KCL = 4112;
constexpr int NWAVES = 8, NTHREADS = 512;
constexpr int LDS_BYTES = 153600;
constexpr int LDS_SLOT = LDS_BYTES - 64;
constexpr float LOG2E = 1.4426950408889634f;
constexpr float RMS_EPS = 1e-6f;

constexpr size_t O_Y = 0;
constexpr size_t O_LATP = (size_t)TT * DM;
constexpr size_t O_ROPEP = O_LATP + (size_t)TP * 256;
constexpr size_t O_KP = O_ROPEP + (size_t)TP * 32;
constexpr size_t O_VP = O_KP + 4 * 128 * 256;
constexpr size_t O_LATS = O_VP + 4 * 128 * 256;
constexpr size_t O_ROPES = O_LATS + (size_t)TS * 256;
constexpr size_t O_KS = O_ROPES + (size_t)TS * 32;
constexpr size_t O_VS = O_KS + (size_t)TS * 256;

constexpr size_t al256(size_t x) { return (x + 255) & ~(size_t)255; }
constexpr size_t WS_CTL = 0, CTL_BYTES = 65536;
constexpr size_t WS_WGU = CTL_BYTES;
constexpr size_t WS_WD = WS_WGU + 4 * (size_t)FF2 * DM * 2;
constexpr size_t WS_W3 = WS_WD + 4 * (size_t)DM * FF * 2;
constexpr size_t WS_WUQT = WS_W3 + 768 * (size_t)DM * 2;
constexpr size_t WS_WABST = WS_WUQT + 1536 * (size_t)QL * 2;
constexpr size_t WS_WUKT = WS_WABST + 4608 * (size_t)QL * 2;
constexpr size_t WS_WUVT = WS_WUKT + 1024 * 256 * 2;
constexpr size_t WS_WOT = WS_WUVT + 1024 * 256 * 2;
constexpr size_t WS_WOVT = WS_WOT + (size_t)DM * DM * 2;
constexpr size_t WS_WKVT = WS_WOVT + (size_t)DM * 4096 * 2;
constexpr size_t WS_WQST = WS_WKVT + 512 * (size_t)DM * 2;
constexpr size_t WS_WOST = WS_WQST + (size_t)DM * DM * 2;
constexpr size_t WS_ROPE = WS_WOST + (size_t)DM * DM * 2;
constexpr size_t WS_BT = WS_ROPE + (size_t)KCL * 32 * 4;
constexpr size_t WS_XB = al256(WS_BT + 16 * 256 * 4);
constexpr size_t WS_SSQX = WS_XB + (size_t)TT * DM * 2;
constexpr size_t WS_SSQQ = WS_SSQX + (size_t)TT * 16 * 4;
constexpr size_t WS_SSQL = WS_SSQQ + (size_t)TT * 16 * 4;
constexpr size_t WS_SSQS = WS_SSQL + (size_t)TT * 16 * 4;
constexpr size_t WS_ACT = WS_SSQS + (size_t)TS * 32 * 4;
constexpr size_t WS_QB = WS_ACT;
constexpr size_t WS_QS = WS_ACT;
constexpr size_t WS_RB = WS_ACT + (size_t)TT * FF * 2;
constexpr size_t WS_CQB = WS_RB;
constexpr size_t WS_CKV = WS_CQB + (size_t)TT * QL * 2;
constexpr size_t WS_LATB = WS_CKV + (size_t)TT * CKVW * 4;
constexpr size_t WS_OB = WS_RB;
static_assert(WS_LATB + (size_t)TP * 256 * 2 >= WS_OB + (size_t)TT * DM * 2, "alias");
constexpr size_t WS_QA = WS_LATB + (size_t)TP * 256 * 2;
constexpr size_t WS_KNV = WS_QA + (size_t)TS * 4608 * 2;
constexpr size_t WS_KRB = WS_KNV + (size_t)TP * 2048 * 2;
constexpr size_t WS_OA = WS_KRB + (size_t)TP * 32 * 2;
constexpr size_t WS_KVSB = WS_OA + (size_t)TS * 4096 * 2;
constexpr size_t WS_KS = WS_KVSB + (size_t)TP * 512 * 2;
constexpr size_t WS_KC = WS_KS + (size_t)32 * 192 * 512 * 2;
constexpr size_t WS_END = WS_KC + (size_t)32 * KCL * CKVW * 2 + 65536;

DI unsigned pk2(float lo, float hi) {
    typedef float f2 __attribute__((ext_vector_type(2))); typedef __bf16 b2 __attribute__((ext_vector_type(2)));
    f2 v = {lo, hi}; b2 b = __builtin_convertvector(v, b2); return __builtin_bit_cast(unsigned, b);
}
DI unsigned short f2bf(float f) { return (unsigned short)(pk2(f, 0.f) & 0xffffu); }
DI float wave_sum(float v) {
#pragma unroll
    for (int o = 1; o < 64; o <<= 1) v += __shfl_xor(v, o);
    return v;
}
DI float row_rstd(const float* ssq, int row, int n4, float inv_dim) {
    const f32x4* p = (const f32x4*)(ssq + (size_t)row * 16);
    float s = 0.f;
    for (int i = 0; i < n4; ++i) { const f32x4 v = p[i]; s += (v.x + v.y) + (v.z + v.w); }
    return rsqrtf(s * inv_dim + RMS_EPS);
}
DI float srow_rstd(const float* ssqs, int rl) { const f32x4* p4 = (const f32x4*)(ssqs + (size_t)rl * 32); float s = 0.f;
#pragma unroll
    for (int i = 0; i < 8; ++i) { const f32x4 v = p4[i]; s += (v.x + v.y) + (v.z + v.w); }
    return rsqrtf(s * (1.0f / DM) + RMS_EPS); }
DI int otid() { int t = threadIdx.x; asm volatile("" : "+v"(t)); return t; }
DI float halfmax(float m) { auto rr = __builtin_amdgcn_permlane32_swap(__float_as_uint(m), __float_as_uint(m), false, false); return fmaxf(__uint_as_float(rr[0]), __uint_as_float(rr[1])); }
DI int crow(int i, int h) { return (i & 3) + 8 * (i >> 2) + 4 * h; }
#define MFMA32(a, b, c) __builtin_amdgcn_mfma_f32_32x32x16_bf16((a), (b), (c), 0, 0, 0)

namespace pg8 {
constexpr int BM = 256, BK = 64, HALF = 128, HTB = HALF * BK * 2, STAGE_BYTES = 8 * HTB, NXCD = 8, WGM = 8;
__host__ __device__ __forceinline__ int lds_byte(int r, int c) { const int st = (r >> 4) * 2 + (c >> 5), rr = r & 15, cc = c & 31, ob = rr * 64 + cc * 2; return st * 1024 + (ob ^ (((ob >> 9) & 1) << 5)); }
__host__ __device__ __forceinline__ void stage_rc(int b, int& R, int& C) { const int st = b / 1024, sb = b % 1024, swz = sb ^ (((sb >> 9) & 1) << 5); R = (st >> 1) * 16 + swz / 64; C = (st & 1) * 32 + (swz % 64) / 2; }
__host__ __device__ __forceinline__ int perm32(int rho) { const int n = rho >> 4, i = rho & 15; return 8 * (i >> 2) + 4 * n + (i & 3); }

struct Unit { int pm, pn; };
struct Gemm { const bf16_t* A; const bf16_t* Bt; int lda, ldb, K; };

struct StaticOrder {
    int nM, nN, nwg, G, c;
    __device__ void init(int M, int N, int G_, int c_) { nM = M / BM; nN = N / BM; nwg = nM * nN; G = G_; c = c_; }
    __device__ bool next(int i, Unit& u) const {
        const long L = (long)i * G + c; if (L >= nwg) return false;
        int wgid = (int)L; { const int q = nwg / NXCD, r = nwg % NXCD, xcd = wgid % NXCD, off = wgid / NXCD; wgid = (xcd < r ? xcd * (q + 1) : r * (q + 1) + (xcd - r) * q) + off; }
        const int nig = WGM * nN, gid = wgid / nig, fm = gid * WGM, gsz = (nM - fm) < WGM ? (nM - fm) : WGM;
        u.pm = fm + ((wgid % nig) % gsz); u.pn = (wgid % nig) / gsz; return true;
    }
};

template <class Epi>
__device__ __forceinline__ void gemm_phase(lds_u8* lds, const Gemm g, const StaticOrder& S, const Epi& E) {
    const int tid = otid(), wid = __builtin_amdgcn_readfirstlane(tid >> 6), lane = tid & 63, wr = wid >> 2, wc = wid & 3, fr = lane & 15, fq = lane >> 4;
    const int K = g.K, nt = K / BK;
    unsigned voffA[2], voffB[2];
#pragma unroll
    for (int i = 0; i < 2; ++i) { int R, C; stage_rc(tid * 16 + i * 8192, R, C); const int Rb = Epi::PERM ? ((R & ~31) + perm32(R & 31)) : R;
        voffA[i] = (unsigned)(R * g.lda + C) * 2u; voffB[i] = (unsigned)(Rb * g.ldb + C) * 2u; }
    const size_t kstep = (size_t)(BK * 2);
    const size_t hstepA = (size_t)HALF * g.lda * 2, hstepB = (size_t)HALF * g.ldb * 2;
    const size_t tstepA = 2 * hstepA, tstepB = 2 * hstepB;
    const unsigned ldsw = (unsigned)wid * 1024u;
    const int aoff = lds_byte(wr * 64 + fr, fq * 8), boff = lds_byte(wc * 32 + fr, fq * 8);
#define PG8_SA(b, h) (((b) * 2 + (h)) * HTB)
#define PG8_SB(b, h) ((4 + (b) * 2 + (h)) * HTB)
#define PG8_STAGE(bufoff, gbase, voff) do { _Pragma("unroll") for (int _i = 0; _i < 2; ++_i) \
        __builtin_amdgcn_global_load_lds((const unsigned*)((const char*)(gbase) + (voff)[_i]), (LAS unsigned*)(lds + (bufoff) + ldsw + _i * 8192), 16, 0, 0); } while (0)
#define PG8_LDA(dst, b, h) do { _Pragma("unroll") for (int m = 0; m < 4; ++m) _Pragma("unroll") for (int k = 0; k < 2; ++k) dst[m][k] = *(const LAS bf16x8*)(lds + PG8_SA(b, h) + aoff + m * 2048 + k * 1024); } while (0)
#define PG8_LDB(dst, b, h) do { _Pragma("unroll") for (int n = 0; n < 2; ++n) _Pragma("unroll") for (int k = 0; k < 2; ++k) dst[n][k] = *(const LAS bf16x8*)(lds + PG8_SB(b, h) + boff + n * 2048 + k * 1024); } while (0)
#define PG8_MMA(ai, bj, At, Bt) do { __builtin_amdgcn_s_setprio(1); _Pragma("unroll") for (int m = 0; m < 4; ++m) _Pragma("unroll") for (int n = 0; n < 2; ++n) _Pragma("unroll") for (int k = 0; k < 2; ++k) \
        acc[ai][bj][m][n] = __builtin_amdgcn_mfma_f32_16x16x32_bf16(Bt[n][k], At[m][k], acc[ai][bj][m][n], 0, 0, 0); __builtin_amdgcn_s_setprio(0); } while (0)
#define PG8_WAIT_V(n) asm volatile("s_waitcnt vmcnt(" #n ")" ::: "memory")
#define PG8_WAIT_L(n) asm volatile("s_waitcnt lgkmcnt(" #n ")" ::: "memory")
#define PG8_BAR __builtin_amdgcn_s_barrier()
#define PG8_SCHED __builtin_amdgcn_sched_barrier(0)
    Unit cur, nxt; int ui = 0;
    if (!S.next(0, cur)) return;
    f32x4 acc[2][2][4][2];
#pragma unroll
    for (int a = 0; a < 2; ++a)
#pragma unroll
        for (int b = 0; b < 2; ++b)
#pragma unroll
            for (int m = 0; m < 4; ++m)
#pragma unroll
                for (int n = 0; n < 2; ++n) acc[a][b][m][n] = (f32x4){0.f, 0.f, 0.f, 0.f};
    bf16x8 At[4][2], B0[2][2], B1[2][2];
    const char* cA = (const char*)g.A + (size_t)cur.pm * tstepA; const char* cB = (const char*)g.Bt + (size_t)cur.pn * tstepB;
    PG8_STAGE(PG8_SB(0, 0), cB, voffB); PG8_STAGE(PG8_SB(0, 1), cB + hstepB, voffB); PG8_STAGE(PG8_SA(0, 0), cA, voffA); PG8_STAGE(PG8_SA(0, 1), cA + hstepA, voffA);
    if (wr == 1) PG8_BAR;
    PG8_WAIT_V(2); PG8_BAR;
    PG8_STAGE(PG8_SB(1, 0), cB + kstep, voffB); PG8_STAGE(PG8_SA(1, 0), cA + kstep, voffA); PG8_STAGE(PG8_SB(1, 1), cB + hstepB + kstep, voffB);
    PG8_WAIT_V(6); PG8_BAR;
    for (;;) {
        const bool has_next = S.next(ui + 1, nxt);
        const char* nA = has_next ? (const char*)g.A + (size_t)nxt.pm * tstepA : cA; const char* nB = has_next ? (const char*)g.Bt + (size_t)nxt.pn * tstepB : cB;
        for (int t = 0; t < nt; t += 2) {
            const bool last = (t == nt - 2);
            const char* a1 = cA + (size_t)(t + 1) * kstep;
            const char* a2 = last ? nA : cA + (size_t)(t + 2) * kstep; const char* b2 = last ? nB : cB + (size_t)(t + 2) * kstep;
            const char* a3 = a2 + kstep; const char* b3 = b2 + kstep;
            PG8_LDB(B0, 0, 0); PG8_LDB(B1, 0, 1); PG8_SCHED; PG8_LDA(At, 0, 0); PG8_STAGE(PG8_SA(1, 1), a1 + hstepA, voffA);
            PG8_WAIT_V(8); PG8_WAIT_L(0); PG8_BAR; PG8_MMA(0, 0, At, B0); PG8_MMA(0, 1, At, B1); PG8_BAR; PG8_SCHED;
            PG8_LDA(At, 0, 1); PG8_STAGE(PG8_SB(0, 0), b2, voffB); PG8_STAGE(PG8_SB(0, 1), b2 + hstepB, voffB); PG8_STAGE(PG8_SA(0, 0), a2, voffA);
            PG8_WAIT_V(8); PG8_WAIT_L(0); PG8_BAR; PG8_MMA(1, 0, At, B0); PG8_MMA(1, 1, At, B1); PG8_BAR; PG8_SCHED;
            PG8_LDB(B0, 1, 0); PG8_LDB(B1, 1, 1); PG8_SCHED; PG8_LDA(At, 1, 0); PG8_STAGE(PG8_SA(0, 1), a2 + hstepA, voffA);
            PG8_WAIT_V(8); PG8_WAIT_L(0); PG8_BAR; PG8_MMA(0, 0, At, B0); PG8_MMA(0, 1, At, B1); PG8_BAR; PG8_SCHED;
            PG8_LDA(At, 1, 1); PG8_STAGE(PG8_SB(1, 0), b3, voffB); PG8_STAGE(PG8_SB(1, 1), b3 + hstepB, voffB); PG8_STAGE(PG8_SA(1, 0), a3, voffA);
            PG8_WAIT_V(8); PG8_WAIT_L(0); PG8_BAR; PG8_MMA(1, 0, At, B0); PG8_MMA(1, 1, At, B1); PG8_BAR; PG8_SCHED;
        }
        if (wr == 0) PG8_BAR;
        { const int l2 = otid() & 63; E(acc, cur, wr, wc, l2 & 15, l2 >> 4); }
        if (!has_next) break;
#pragma unroll
        for (int a = 0; a < 2; ++a)
#pragma unroll
            for (int b = 0; b < 2; ++b)
#pragma unroll
                for (int m = 0; m < 4; ++m)
#pragma unroll
                    for (int n = 0; n < 2; ++n) acc[a][b][m][n] = (f32x4){0.f, 0.f, 0.f, 0.f};
        cur = nxt; cA = nA; cB = nB; ++ui;
        if (wr == 1) PG8_BAR;
    }
    PG8_WAIT_V(0);
    PG8_BAR;
#undef PG8_SA
#undef PG8_SB
#undef PG8_STAGE
#undef PG8_LDA
#undef PG8_LDB
#undef PG8_MMA
#undef PG8_WAIT_V
#undef PG8_WAIT_L
#undef PG8_BAR
#undef PG8_SCHED
}

typedef const f32x4 (&AccRef)[2][2][4][2];
DI void unit_rstd(float (&rs)[2][4], const float* ssq, int rowbase, int n4, float inv_dim, float mul) {
    const int L = otid() & 63; float own[2]; f32x4 t[2][4];
#pragma unroll
    for (int ai = 0; ai < 2; ++ai)
#pragma unroll
        for (int i = 0; i < 4; ++i) t[ai][i] = (i < n4) ? *(const f32x4*)(ssq + (size_t)(rowbase + ai * HALF + L) * 16 + 4 * i) : (f32x4){0.f, 0.f, 0.f, 0.f};
#pragma unroll
    for (int ai = 0; ai < 2; ++ai) { float s = 0.f;
#pragma unroll
        for (int i = 0; i < 4; ++i) s += (t[ai][i].x + t[ai][i].y) + (t[ai][i].z + t[ai][i].w);
        own[ai] = rsqrtf(s * inv_dim + RMS_EPS) * mul; }
#pragma unroll
    for (int ai = 0; ai < 2; ++ai)
#pragma unroll
        for (int m = 0; m < 4; ++m) rs[ai][m] = __shfl(own[ai], m * 16 + (L & 15));
}
DI void unit_rstd_s(float (&rs)[2][4], const float* ssqs, int rlbase, float mul) {
    const int L = otid() & 63; float own[2];
#pragma unroll
    for (int ai = 0; ai < 2; ++ai) { f32x4 t[8]; float s = 0.f;
#pragma unroll
        for (int i = 0; i < 8; ++i) t[i] = *(const f32x4*)(ssqs + (size_t)(rlbase + ai * HALF + L) * 32 + 4 * i);
#pragma unroll
        for (int i = 0; i < 8; ++i) s += (t[i].x + t[i].y) + (t[i].z + t[i].w);
        own[ai] = rsqrtf(s * (1.0f / DM) + RMS_EPS) * mul; asm volatile("" ::: "memory"); }
#pragma unroll
    for (int ai = 0; ai < 2; ++ai)
#pragma unroll
        for (int m = 0; m < 4; ++m) rs[ai][m] = __shfl(own[ai], m * 16 + (L & 15));
}
struct EpiSwiGLU {
    static constexpr bool PERM = true;
    bf16_t* O; const float* ssq; const float* ssqs;
    DI void operator()(AccRef acc, const Unit& u, int wr, int wc, int fr, int fq) const {
        const int row0 = u.pm * BM + wr * 64 + fr, col0 = u.pn * 128 + wc * 32 + 8 * fq;
        float rsv[2][4];
        if (u.pm * BM >= TP) unit_rstd_s(rsv, ssqs, u.pm * BM - TP + wr * 64, 1.0f); else unit_rstd(rsv, ssq, u.pm * BM + wr * 64, 4, 1.0f / DM, 1.0f);
#pragma unroll
        for (int ai = 0; ai < 2; ++ai)
#pragma unroll
            for (int m = 0; m < 4; ++m) {
                const int row = row0 + ai * HALF + m * 16; const float rs = rsv[ai][m];
                float o[8];
#pragma unroll
                for (int n = 0; n < 2; ++n)
#pragma unroll
                    for (int j = 0; j < 4; ++j) { const float gt = acc[ai][0][m][n][j] * rs, up = acc[ai][1][m][n][j] * rs;
                        const float sg = gt * __builtin_amdgcn_rcpf(1.0f + __builtin_amdgcn_exp2f(-gt * LOG2E)); o[n * 4 + j] = sg * up; }
                u32x4 w; w.x = pk2(o[0], o[1]); w.y = pk2(o[2], o[3]); w.z = pk2(o[4], o[5]); w.w = pk2(o[6], o[7]);
                *(u32x4*)(O + (size_t)row * FF + col0) = w;
            }
    }
};
struct EpiResid {
    static constexpr bool PERM = true;
    const float* Xin; float* X; bf16_t* XB; float* ssq; float scale; int row_base;
    DI void operator()(AccRef acc, const Unit& u, int wr, int wc, int fr, int fq) const {
        const int row0 = row_base + u.pm * BM + wr * 64 + fr, col0 = u.pn * BM + wc * 32 + 8 * fq;
#pragma unroll
        for (int ai = 0; ai < 2; ++ai) {
            f32x4 xo[4][2][2];
#pragma unroll
            for (int m = 0; m < 4; ++m)
#pragma unroll
                for (int bj = 0; bj < 2; ++bj)
#pragma unroll
                    for (int n = 0; n < 2; ++n) xo[m][bj][n] = *(const f32x4*)(Xin + (size_t)(row0 + ai * HALF + m * 16) * DM + col0 + bj * HALF + n * 4);
#pragma unroll
            for (int m = 0; m < 4; ++m) {
                const int row = row0 + ai * HALF + m * 16; float ss = 0.f;
#pragma unroll
                for (int bj = 0; bj < 2; ++bj) { const size_t off = (size_t)row * DM + col0 + bj * HALF;
                    const f32x4 x0 = xo[m][bj][0] + acc[ai][bj][m][0] * scale, x1 = xo[m][bj][1] + acc[ai][bj][m][1] * scale;
                    *(f32x4*)(X + off) = x0; *(f32x4*)(X + off + 4) = x1;
                    u32x4 w; w.x = pk2(x0.x, x0.y); w.y = pk2(x0.z, x0.w); w.z = pk2(x1.x, x1.y); w.w = pk2(x1.z, x1.w); *(u32x4*)(XB + off) = w;
                    ss += ((x0.x * x0.x + x0.y * x0.y) + (x0.z * x0.z + x0.w * x0.w)) + ((x1.x * x1.x + x1.y * x1.y) + (x1.z * x1.z + x1.w * x1.w)); }
                ss += __shfl_xor(ss, 16); ss += __shfl_xor(ss, 32);
                if (fq == 0) ssq[(size_t)row * 16 + u.pn * 4 + wc] = ss;
            }
            asm volatile("" ::: "memory");
        }
    }
};
struct EpiG3 {
    static constexpr bool PERM = true;
    const float* ssqx; bf16_t* CQB; float* CKV; bf16_t* LATB; float* ssqq; float* ssql; const float* ssqs;
    DI void operator()(AccRef acc, const Unit& u, int wr, int wc, int fr, int fq) const {
        const int row0 = u.pm * BM + wr * 64 + fr;
        float rsv[2][4];
        if (u.pm * BM >= TP) unit_rstd_s(rsv, ssqs, u.pm * BM - TP + wr * 64, 1.0f); else unit_rstd(rsv, ssqx, u.pm * BM + wr * 64, 4, 1.0f / DM, 1.0f);
#pragma unroll
        for (int ai = 0; ai < 2; ++ai)
#pragma unroll
            for (int m = 0; m < 4; ++m) {
                const int row = row0 + ai * HALF + m * 16; const float rs = rsv[ai][m];
#pragma unroll
                for (int bj = 0; bj < 2; ++bj) {
                    const int reg = u.pn * 2 + bj;
                    const f32x4 v0 = acc[ai][bj][m][0] * rs, v1 = acc[ai][bj][m][1] * rs;
                    const int c0 = reg * 128 + wc * 32 + 8 * fq;
                    if (reg < 5) {
                        float ss = (v0.x * v0.x + v0.y * v0.y) + (v0.z * v0.z + v0.w * v0.w) + (v1.x * v1.x + v1.y * v1.y) + (v1.z * v1.z + v1.w * v1.w);
                        ss += __shfl_xor(ss, 16); ss += __shfl_xor(ss, 32);
                        u32x4 w; w.x = pk2(v0.x, v0.y); w.y = pk2(v0.z, v0.w); w.z = pk2(v1.x, v1.y); w.w = pk2(v1.z, v1.w);
                        if (reg < 3) {
                            *(u32x4*)(CQB + (size_t)row * QL + c0) = w;
                            if (fq == 0) ssqq[(size_t)row * 16 + reg * 4 + wc] = ss;
                        } else {
                            const int lc = c0 - 384;
                            *(f32x4*)(CKV + (size_t)row * CKVW + lc) = v0; *(f32x4*)(CKV + (size_t)row * CKVW + lc + 4) = v1;
                            if (row < TP) *(u32x4*)(LATB + (size_t)row * 256 + lc) = w;
                            if (fq == 0) ssql[(size_t)row * 16 + (reg - 3) * 4 + wc] = ss;
                        }
                    } else if (wc == 0) {
                        *(f32x4*)(CKV + (size_t)row * CKVW + 256 + 8 * fq) = v0; *(f32x4*)(CKV + (size_t)row * CKVW + 256 + 8 * fq + 4) = v1;
                    }
                }
            }
    }
};
struct EpiQ {
    static constexpr bool PERM = false;
    const float* ssqq; const float* rope; bf16_t* O; int ldo, row_base, sample, mod, rem; float qscale;
    DI void operator()(AccRef acc, const Unit& u, int wr, int wc, int fr, int fq) const {
        const int row0 = u.pm * BM + wr * 64 + fr;
        float rsv[2][4]; unit_rstd(rsv, ssqq, row_base + u.pm * BM + wr * 64, 3, 1.0f / QL, qscale);
#pragma unroll
        for (int ai = 0; ai < 2; ++ai)
#pragma unroll
            for (int m = 0; m < 4; ++m) {
                const int rl = row0 + ai * HALF + m * 16; const float rs = rsv[ai][m];
                const int pos = sample ? 4096 + (rl & 15) : (rl & 4095);
#pragma unroll
                for (int bj = 0; bj < 2; ++bj) {
                    const int g32 = u.pn * 8 + bj * 4 + wc;
                    f32x4 v0 = acc[ai][bj][m][0] * rs, v1 = acc[ai][bj][m][1] * rs;
                    if (g32 % mod == rem) { const f32x4 cs = *(const f32x4*)(rope + (size_t)pos * 32 + 4 * fq), sn = *(const f32x4*)(rope + (size_t)pos * 32 + 16 + 4 * fq);
                        const f32x4 o0 = v0 * cs - v1 * sn, o1 = v0 * sn + v1 * cs; v0 = o0; v1 = o1; }
                    const size_t off = (size_t)rl * ldo + g32 * 32 + 4 * fq;
                    u32x2 w0, w1; w0.x = pk2(v0.x, v0.y); w0.y = pk2(v0.z, v0.w); w1.x = pk2(v1.x, v1.y); w1.y = pk2(v1.z, v1.w);
                    *(u32x2*)(O + off) = w0; *(u32x2*)(O + off + 16) = w1;
                }
            }
    }
};
struct EpiRowScale {
    static constexpr bool PERM = true;
    const float* ssq; int n4; float inv_dim, oscale; bf16_t* O; int ldo;
    DI void operator()(AccRef acc, const Unit& u, int wr, int wc, int fr, int fq) const {
        const int row0 = u.pm * BM + wr * 64 + fr, col0 = u.pn * BM + wc * 32 + 8 * fq;
        float rsv[2][4]; unit_rstd(rsv, ssq, u.pm * BM + wr * 64, n4, inv_dim, oscale);
#pragma unroll
        for (int ai = 0; ai < 2; ++ai)
#pragma unroll
            for (int m = 0; m < 4; ++m) {
                const int row = row0 + ai * HALF + m * 16; const float rs = rsv[ai][m];
#pragma unroll
                for (int bj = 0; bj < 2; ++bj) { const f32x4 v0 = acc[ai][bj][m][0] * rs, v1 = acc[ai][bj][m][1] * rs;
                    u32x4 w; w.x = pk2(v0.x, v0.y); w.y = pk2(v0.z, v0.w); w.z = pk2(v1.x, v1.y); w.w = pk2(v1.z, v1.w);
                    *(u32x4*)(O + (size_t)row * ldo + col0 + bj * HALF) = w; }
            }
    }
};
struct EpiKV {
    static constexpr bool PERM = true;
    const float* ssqx; bf16_t* KVSB; bf16_t* KS; float* out; const float* ssqs;
    DI void operator()(AccRef acc, const Unit& u, int wr, int wc, int fr, int fq) const {
        const int row0 = u.pm * BM + wr * 64 + fr; const bool isv = (u.pn == 1);
        float rsv[2][4];
        if (u.pm * BM >= TP) unit_rstd_s(rsv, ssqs, u.pm * BM - TP + wr * 64, 1.0f); else unit_rstd(rsv, ssqx, u.pm * BM + wr * 64, 4, 1.0f / DM, 1.0f);
#pragma unroll
        for (int ai = 0; ai < 2; ++ai)
#pragma unroll
            for (int m = 0; m < 4; ++m) {
                const int row = row0 + ai * HALF + m * 16; const float rs = rsv[ai][m];
                const bool smp = row >= TP; const int b = smp ? (row - TP) >> 4 : row >> 12, pos = smp ? (row - TP) & 15 : row & 4095;
#pragma unroll
                for (int bj = 0; bj < 2; ++bj) {
                    const f32x4 v0 = acc[ai][bj][m][0] * rs, v1 = acc[ai][bj][m][1] * rs; const int c = bj * HALF + wc * 32 + 8 * fq;
                    if (smp) { float* o = out + (isv ? O_VS : O_KS) + (size_t)(row - TP) * 256 + c; *(f32x4*)o = v0; *(f32x4*)(o + 4) = v1; }
                    else if (pos >= SEQ - 128) { float* o = out + (isv ? O_VP : O_KP) + ((size_t)b * 128 + (pos - (SEQ - 128))) * 256 + c; *(f32x4*)o = v0; *(f32x4*)(o + 4) = v1; }
                    u32x4 w; w.x = pk2(v0.x, v0.y); w.y = pk2(v0.z, v0.w); w.z = pk2(v1.x, v1.y); w.w = pk2(v1.z, v1.w);
                    if (smp) *(u32x4*)(KS + ((size_t)b * 192 + 128 + pos) * 512 + u.pn * 256 + c) = w;
                    else *(u32x4*)(KVSB + (size_t)row * 512 + u.pn * 256 + c) = w;
                }
            }
    }
};
}

typedef short v4i16_t __attribute__((ext_vector_type(4)));
DI s16x4 tr16(const lds_u8* p) { return __builtin_bit_cast(s16x4, __builtin_amdgcn_ds_read_tr16_b64_v4i16((LAS v4i16_t*)p)); }

template <int DQK, int DROW, int KSPLIT, int KGAP, int VOFF, int NDB, int NBLK, bool BIAS>
DI void flash_unit(lds_u8* lds, const bf16_t* qrow, const bf16_t* kA, int pitchA, int da8, const bf16_t* kB, int pitchB,
                   int dofs, int j0, int ntiles, int my_tiles, int kvlimit,
                   float m_init, float l_init, const LAS float* bias_tab, int bias_off, bf16_t* orow, bool store_ok) {
    constexpr int CPR = DROW / 8, ROWB = DROW * 2 + 16, TILEB = 64 * ROWB;
    constexpr int NCH = 64 * CPR, NKR = (NCH + 511) / 512, ND0 = DQK / 16;
    const int tid = otid(), lane = tid & 63, r = lane & 31, h = lane >> 5;
    bf16x8 qf[ND0];
#pragma unroll
    for (int d0 = 0; d0 < ND0; ++d0) qf[d0] = *(const bf16x8*)(qrow + 16 * d0 + 8 * h);
    f32x16 O[NDB];
#pragma unroll
    for (int d = 0; d < NDB; ++d)
#pragma unroll
        for (int i = 0; i < 16; ++i) O[d][i] = 0.f;
    float mrun = m_init, lrun = l_init;
    u32x4 kreg[3][NKR];
    const u32x4 zero4 = {0u, 0u, 0u, 0u};
#define FL_LOAD(st, jt) do { const int kv0_ = (jt) * 64; \
    _Pragma("unroll") for (int i_ = 0; i_ < NKR; ++i_) { const int c_ = tid + i_ * 512; if ((NCH % 512 == 0) || c_ < NCH) { const int row_ = c_ / CPR, cc_ = c_ % CPR, kv_ = kv0_ + row_; \
        const bf16_t* s_ = (cc_ < da8) ? kA + (size_t)kv_ * pitchA + cc_ * 8 : kB + (size_t)kv_ * pitchB + (cc_ - da8) * 8; \
        kreg[st][i_] = (kv_ < kvlimit) ? *(const u32x4*)s_ : zero4; } } } while (0)
#define FL_STORE(st, buf) do { \
    _Pragma("unroll") for (int i_ = 0; i_ < NKR; ++i_) { const int c_ = tid + i_ * 512; if ((NCH % 512 == 0) || c_ < NCH) { const int row_ = c_ / CPR, cc_ = c_ % CPR; \
        *(LAS u32x4*)(lds + (buf) * TILEB + row_ * ROWB + cc_ * 16) = kreg[st][i_]; } } } while (0)
    const int nt = ntiles - j0;
    FL_LOAD(0, j0); if (nt > 1) FL_LOAD(1, j0 + 1); if (nt > 2) FL_LOAD(2, j0 + 2);
    FL_STORE(0, 0); if (nt > 3) FL_LOAD(0, j0 + 3); __syncthreads();
    const int vlane = (4 * h + ((lane & 15) >> 2)) * ROWB + (VOFF + dofs + 16 * ((lane >> 4) & 1) + 4 * (lane & 3)) * 2;
    for (int t0 = 0; t0 < nt; t0 += 3) {
#pragma unroll
      for (int s3 = 0; s3 < 3; ++s3) {
        const int t = t0 + s3;
        if (t < nt) {
        const int j = j0 + t, buf = t & 1;
        if (j < my_tiles) {
            const lds_u8* Kt = lds + buf * TILEB;
#pragma unroll
            for (int ss = 0; ss < 2; ss += NBLK) {
                f32x16 S[NBLK];
#pragma unroll
                for (int b = 0; b < NBLK; ++b) {
#pragma unroll
                    for (int i = 0; i < 16; ++i) S[b][i] = 0.f;
                    const lds_u8* kp = Kt + ((ss + b) * 32 + r) * ROWB + h * 16;
#pragma unroll
                    for (int d0 = 0; d0 < ND0; ++d0) { const bf16x8 kf = *(const LAS bf16x8*)(kp + (16 * d0 + (d0 >= KSPLIT ? KGAP : 0)) * 2); S[b] = MFMA32(kf, qf[d0], S[b]); }
                }
                if (BIAS) {
#pragma unroll
                    for (int b = 0; b < NBLK; ++b)
#pragma unroll
                        for (int i = 0; i < 16; ++i) S[b][i] += bias_tab[j * 64 + (ss + b) * 32 + crow(i, h) + bias_off];
                }
                if (j * 64 + 64 > kvlimit) {
#pragma unroll
                    for (int b = 0; b < NBLK; ++b)
#pragma unroll
                        for (int i = 0; i < 16; ++i) if (j * 64 + (ss + b) * 32 + crow(i, h) >= kvlimit) S[b][i] = -1e30f;
                }
                float mt = S[0][0];
#pragma unroll
                for (int b = 0; b < NBLK; ++b)
#pragma unroll
                    for (int i = 0; i < 16; ++i) mt = fmaxf(mt, S[b][i]);
                mt = halfmax(mt);
                if (__any(mt > mrun)) {
                    const float mn0 = fmaxf(mrun, mt); const float alpha = __builtin_amdgcn_exp2f(mrun - mn0); mrun = mn0; lrun *= alpha;
#pragma unroll
                    for (int d = 0; d < NDB; ++d)
#pragma unroll
                        for (int i = 0; i < 16; ++i) O[d][i] *= alpha;
                }
                const float mn = mrun;
                float ps = 0.f;
#pragma unroll
                for (int b = 0; b < NBLK; ++b)
#pragma unroll
                    for (int i = 0; i < 16; ++i) { const float pe = __builtin_amdgcn_exp2f(S[b][i] - mn); S[b][i] = pe; ps += pe; }
                lrun += ps;
                bf16x8 pk[NBLK][2];
#pragma unroll
                for (int b = 0; b < NBLK; ++b)
#pragma unroll
                    for (int s = 0; s < 2; ++s) { u32x4 w; w.x = pk2(S[b][8 * s], S[b][8 * s + 1]); w.y = pk2(S[b][8 * s + 2], S[b][8 * s + 3]); w.z = pk2(S[b][8 * s + 4], S[b][8 * s + 5]); w.w = pk2(S[b][8 * s + 6], S[b][8 * s + 7]);
                        pk[b][s] = __builtin_bit_cast(bf16x8, w); }
                const lds_u8* vp = Kt + vlane;
#pragma unroll
                for (int d = 0; d < NDB; ++d) {
#pragma unroll
                    for (int b = 0; b < NBLK; ++b)
#pragma unroll
                        for (int s = 0; s < 2; ++s) { const int off = ((ss + b) * 32 + 16 * s) * ROWB + d * 64;
                            const s16x4 lo = tr16(vp + off), hi = tr16(vp + off + 8 * ROWB);
                            const bf16x8 vf = __builtin_shufflevector(lo, hi, 0, 1, 2, 3, 4, 5, 6, 7);
                            O[d] = MFMA32(vf, pk[b][s], O[d]); }
                }
            }
        }
        if (t + 1 < nt) FL_STORE((s3 + 1) % 3, buf ^ 1);
        if (t + 4 < nt) FL_LOAD((s3 + 1) % 3, j + 4);
        __syncthreads();
        }
      }
    }
#undef FL_LOAD
#undef FL_STORE
    const float lt = lrun + __shfl_xor(lrun, 32); const float inv = 1.0f / lt;
#pragma unroll
    for (int d = 0; d < NDB; ++d)
#pragma unroll
        for (int k = 0; k < 4; k += 2) {
            unsigned ax = pk2(O[d][4 * k] * inv, O[d][4 * k + 1] * inv), ay = pk2(O[d][4 * k + 2] * inv, O[d][4 * k + 3] * inv);
            unsigned bx = pk2(O[d][4 * k + 4] * inv, O[d][4 * k + 5] * inv), by = pk2(O[d][4 * k + 6] * inv, O[d][4 * k + 7] * inv);
            { auto r0 = __builtin_amdgcn_permlane32_swap(ax, bx, false, false); ax = r0[0]; bx = r0[1]; }
            { auto r1 = __builtin_amdgcn_permlane32_swap(ay, by, false, false); ay = r1[0]; by = r1[1]; }
            if (store_ok) { u32x4 w; w.x = ax; w.y = ay; w.z = bx; w.w = by; *(u32x4*)(orow + dofs + d * 32 + 8 * k + 8 * h) = w; }
        }
}


DI void flash_abs_unit(lds_u8* lds, const bf16_t* qrow, const float* latA, const float* ropeA, const float* latN, const float* ropeN, int dofs, bf16_t* orow) {
    constexpr int ROWB = 592, TR = 32, TILEB = TR * ROWB, ND0 = 18, NDB = 4, NT = 129, KVLIM = 4112;
    const int tid = otid(), lane = tid & 63, r = lane & 31, h = lane >> 5;
    bf16x8 qf[ND0];
#pragma unroll
    for (int d0 = 0; d0 < ND0; ++d0) qf[d0] = *(const bf16x8*)(qrow + 16 * d0 + 8 * h);
    f32x16 O[NDB];
#pragma unroll
    for (int d = 0; d < NDB; ++d)
#pragma unroll
        for (int i = 0; i < 16; ++i) O[d][i] = 0.f;
    float mrun = -1e30f, lrun = 0.f;
    f32x4 kf[2][2][2], kr[2];
#define FA_LOAD(st, jt) do { const int kv0_ = (jt) * TR; \
    _Pragma("unroll") for (int i_ = 0; i_ < 2; ++i_) { const int c_ = tid + i_ * 512; const int row_ = c_ >> 5, cc_ = c_ & 31; int kv_ = kv0_ + row_; kv_ = kv_ < KVLIM ? kv_ : KVLIM - 1;   \
        const float* s_ = (kv_ < 4096 ? latA + (size_t)kv_ * 256 : latN + (size_t)(kv_ - 4096) * 256) + cc_ * 8; \
        kf[st][i_][0] = *(const f32x4*)s_; kf[st][i_][1] = *(const f32x4*)(s_ + 4); } \
    if (tid < 256) { const int row_ = tid >> 3, qq_ = tid & 7; int kv_ = kv0_ + row_; kv_ = kv_ < KVLIM ? kv_ : KVLIM - 1; \
        kr[st] = *(const f32x4*)((kv_ < 4096 ? ropeA + (size_t)kv_ * 32 : ropeN + (size_t)(kv_ - 4096) * 32) + qq_ * 4); } } while (0)
#define FA_STORE(st, buf) do { \
    _Pragma("unroll") for (int i_ = 0; i_ < 2; ++i_) { const int c_ = tid + i_ * 512; const int row_ = c_ >> 5, cc_ = c_ & 31; \
        u32x4 w_; w_.x = pk2(kf[st][i_][0].x, kf[st][i_][0].y); w_.y = pk2(kf[st][i_][0].z, kf[st][i_][0].w); w_.z = pk2(kf[st][i_][1].x, kf[st][i_][1].y); w_.w = pk2(kf[st][i_][1].z, kf[st][i_][1].w); \
        *(LAS u32x4*)(lds + (buf) * TILEB + row_ * ROWB + cc_ * 16) = w_; } \
    if (tid < 256) { const int row_ = tid >> 3, qq_ = tid & 7; u32x2 w2_; w2_.x = pk2(kr[st].x, kr[st].y); w2_.y = pk2(kr[st].z, kr[st].w); \
        *(LAS u32x2*)(lds + (buf) * TILEB + row_ * ROWB + 512 + qq_ * 8) = w2_; } } while (0)
#define FA_COMPUTE(j, buf) do { \
            const lds_u8* Kt = lds + (buf) * TILEB; \
            f32x16 S; \
            _Pragma("unroll") for (int i = 0; i < 16; ++i) S[i] = 0.f; \
            const lds_u8* kp = Kt + r * ROWB + h * 16; \
            _Pragma("unroll") for (int d0 = 0; d0 < ND0; ++d0) { const bf16x8 kfr = *(const LAS bf16x8*)(kp + d0 * 32); S = MFMA32(kfr, qf[d0], S); } \
            if ((j) * TR + TR > KVLIM) { \
                _Pragma("unroll") for (int i = 0; i < 16; ++i) if ((j) * TR + crow(i, h) >= KVLIM) S[i] = -1e30f; \
            } \
            float mt = S[0]; \
            _Pragma("unroll") for (int i = 1; i < 16; ++i) mt = fmaxf(mt, S[i]); \
            mt = halfmax(mt); \
            if (__any(mt > mrun)) { const float mn0 = fmaxf(mrun, mt); const float alpha = __builtin_amdgcn_exp2f(mrun - mn0); mrun = mn0; lrun *= alpha; \
                _Pragma("unroll") for (int d = 0; d < NDB; ++d) _Pragma("unroll") for (int i = 0; i < 16; ++i) O[d][i] *= alpha; } \
            const float mn = mrun; \
            float ps = 0.f; \
            _Pragma("unroll") for (int i = 0; i < 16; ++i) { const float pe = __builtin_amdgcn_exp2f(S[i] - mn); S[i] = pe; ps += pe; } \
            lrun += ps; \
            bf16x8 pk[2]; \
            _Pragma("unroll") for (int s = 0; s < 2; ++s) { u32x4 w; w.x = pk2(S[8 * s], S[8 * s + 1]); w.y = pk2(S[8 * s + 2], S[8 * s + 3]); w.z = pk2(S[8 * s + 4], S[8 * s + 5]); w.w = pk2(S[8 * s + 6], S[8 * s + 7]); \
                pk[s] = __builtin_bit_cast(bf16x8, w); } \
            const lds_u8* vp = Kt + vlane; \
            _Pragma("unroll") for (int d = 0; d < NDB; ++d) _Pragma("unroll") for (int s = 0; s < 2; ++s) { const int off = (16 * s) * ROWB + d * 64; \
                    const s16x4 lo = tr16(vp + off), hi = tr16(vp + off + 8 * ROWB); \
                    const bf16x8 vf = __builtin_shufflevector(lo, hi, 0, 1, 2, 3, 4, 5, 6, 7); \
                    O[d] = MFMA32(vf, pk[s], O[d]); } } while (0)
    const int vlane = (4 * h + ((lane & 15) >> 2)) * ROWB + (dofs + 16 * ((lane >> 4) & 1) + 4 * (lane & 3)) * 2;
    FA_LOAD(0, 0); FA_LOAD(1, 1); FA_STORE(0, 0); FA_LOAD(0, 2); __syncthreads();
    for (int j0 = 0; j0 < NT; j0 += 2) {
        { const int j = j0; FA_COMPUTE(j, 0); if (j + 1 < NT) FA_STORE(1, 1); if (j + 3 < NT) FA_LOAD(1, j + 3); __syncthreads(); }
        if (j0 + 1 < NT) { const int j = j0 + 1; FA_COMPUTE(j, 1); if (j + 1 < NT) FA_STORE(0, 0); if (j + 3 < NT) FA_LOAD(0, j + 3); __syncthreads(); }
    }
#undef FA_COMPUTE
#undef FA_LOAD
#undef FA_STORE
    const float lt = lrun + __shfl_xor(lrun, 32); const float inv = 1.0f / lt;
#pragma unroll
    for (int d = 0; d < NDB; ++d)
#pragma unroll
        for (int k = 0; k < 4; k += 2) {
            unsigned ax = pk2(O[d][4 * k] * inv, O[d][4 * k + 1] * inv), ay = pk2(O[d][4 * k + 2] * inv, O[d][4 * k + 3] * inv);
            unsigned bx = pk2(O[d][4 * k + 4] * inv, O[d][4 * k + 5] * inv), by = pk2(O[d][4 * k + 6] * inv, O[d][4 * k + 7] * inv);
            { auto r0 = __builtin_amdgcn_permlane32_swap(ax, bx, false, false); ax = r0[0]; bx = r0[1]; }
            { auto r1 = __builtin_amdgcn_permlane32_swap(ay, by, false, false); ay = r1[0]; by = r1[1]; }
            u32x4 w; w.x = ax; w.y = ay; w.z = bx; w.w = by; *(u32x4*)(orow + dofs + d * 32 + 8 * k + 8 * h) = w;
        }
}

template <class Epi>
DI void sgemm_phase(lds_u8* lds, const bf16_t* A, int lda, const bf16_t* Bt, int ldb, int K, int nN, int G, int bid, const Epi& E) {
    constexpr int PB = 144, TA = 64 * PB, TB = TA + 256 * PB;
    const int tid = otid(), lane = tid & 63, wave = __builtin_amdgcn_readfirstlane(tid >> 6), r = lane & 31, h = lane >> 5, wm = wave >> 2, wn = wave & 3;
    const int ntiles = 8 * nN, nk = K / 64;
    for (int t = G - 1 - bid; t < ntiles; t += G) {
        const int mi = t & 7, ni = t >> 3;
        const bf16_t* Ap = A + (size_t)(mi * 64 + (tid >> 3)) * lda + (tid & 7) * 8;
        const bf16_t* Bp = Bt + (size_t)(ni * 256 + (tid >> 3)) * ldb + (tid & 7) * 8;
        f32x16 acc0, acc1;
#pragma unroll
        for (int i = 0; i < 16; ++i) { acc0[i] = 0.f; acc1[i] = 0.f; }
        u32x4 ra[4], rb[4][4];
#define SG_LOAD(s, kt) do { ra[s] = *(const u32x4*)(Ap + (kt) * 64); _Pragma("unroll") for (int i_ = 0; i_ < 4; ++i_) rb[s][i_] = *(const u32x4*)(Bp + (size_t)i_ * 64 * ldb + (kt) * 64); } while (0)
#define SG_STORE(s, buf) do { lds_u8* b_ = lds + (buf) * TB + (tid >> 3) * PB + (tid & 7) * 16; *(LAS u32x4*)b_ = ra[s]; \
        _Pragma("unroll") for (int i_ = 0; i_ < 4; ++i_) *(LAS u32x4*)(b_ + TA + i_ * 64 * PB) = rb[s][i_]; } while (0)
#pragma unroll
        for (int s = 0; s < 4; ++s) if (s < nk) SG_LOAD(s, s);
        for (int kt0 = 0; kt0 < nk; kt0 += 4) {
#pragma unroll
            for (int s = 0; s < 4; ++s) {
                const int kt = kt0 + s;
                if (kt < nk) {
                    const int buf = s & 1;
                    SG_STORE(s, buf);
                    if (kt + 4 < nk) SG_LOAD(s, kt + 4);
                    __syncthreads();
                    const lds_u8* Aa = lds + buf * TB + (32 * wm + r) * PB + h * 16;
                    const lds_u8* Bb = lds + buf * TB + TA + (32 * wn + r) * PB + h * 16;
#pragma unroll
                    for (int ks = 0; ks < 4; ++ks) {
                        const bf16x8 af = *(const LAS bf16x8*)(Aa + ks * 32), w0 = *(const LAS bf16x8*)(Bb + ks * 32), w1 = *(const LAS bf16x8*)(Bb + 128 * PB + ks * 32);
                        acc0 = MFMA32(w0, af, acc0); acc1 = MFMA32(w1, af, acc1);
                    }
                }
            }
        }
        __syncthreads();
#undef SG_LOAD
#undef SG_STORE
        E(acc0, acc1, mi * 64 + 32 * wm + r, ni, wn, h);
    }
}
DI float silu_mul(float gt, float up) { return gt * __builtin_amdgcn_rcpf(1.0f + __builtin_amdgcn_exp2f(-gt * LOG2E)) * up; }
struct SEpiSwiGLU {
    bf16_t* O; const float* ssq;
    DI void operator()(const f32x16& a0, const f32x16& a1, int rl, int ni, int wn, int h) const {
        const int row = TP + rl; const float rs = srow_rstd(ssq, rl);
        bf16_t* o = O + (size_t)row * FF + ni * 128 + 32 * wn + 4 * h;
#pragma unroll
        for (int g = 0; g < 4; ++g) { u32x2 w; w.x = pk2(silu_mul(a0[4 * g] * rs, a1[4 * g] * rs), silu_mul(a0[4 * g + 1] * rs, a1[4 * g + 1] * rs));
            w.y = pk2(silu_mul(a0[4 * g + 2] * rs, a1[4 * g + 2] * rs), silu_mul(a0[4 * g + 3] * rs, a1[4 * g + 3] * rs)); *(u32x2*)(o + 8 * g) = w; }
    }
};
struct SEpiResid {
    const float* Xin; float* X; bf16_t* XB; float* ssqs; float scale;
    DI void operator()(const f32x16& a0, int rl, int ni, int wn, int h) const {
        const int row = TP + rl; float ss = 0.f;
        f32x4 xov[4];
#pragma unroll
        for (int g = 0; g < 4; ++g) xov[g] = *(const f32x4*)(Xin + (size_t)row * DM + ni * 128 + 32 * wn + 4 * h + 8 * g);
#pragma unroll
        for (int g = 0; g < 4; ++g) { const size_t off = (size_t)row * DM + ni * 128 + 32 * wn + 4 * h + 8 * g;
            const f32x4 av = (f32x4){a0[4 * g], a0[4 * g + 1], a0[4 * g + 2], a0[4 * g + 3]};
            const f32x4 xo = xov[g]; const f32x4 xn = xo + av * scale; *(f32x4*)(X + off) = xn;
            u32x2 w; w.x = pk2(xn.x, xn.y); w.y = pk2(xn.z, xn.w); *(u32x2*)(XB + off) = w; ss += (xn.x * xn.x + xn.y * xn.y) + (xn.z * xn.z + xn.w * xn.w); }
        ss += __shfl_xor(ss, 32);
        if (h == 0) ssqs[(size_t)rl * 32 + ni * 4 + wn] = ss;
    }
};
struct SEpiG3 {
    const float* ssqx; bf16_t* CQB; float* CKV; float* ssqq;
    DI void operator()(const f32x16& a0, const f32x16& a1, int rl, int ni, int wn, int h) const {
        const int row = TP + rl; const float rs = srow_rstd(ssqx, rl);
#pragma unroll
        for (int blk = 0; blk < 2; ++blk) {
            const int reg = ni * 2 + blk; const int c0 = reg * 128 + 32 * wn + 4 * h;
            f32x4 v[4]; float ss = 0.f;
#pragma unroll
            for (int g = 0; g < 4; ++g) { v[g] = (blk ? (f32x4){a1[4 * g], a1[4 * g + 1], a1[4 * g + 2], a1[4 * g + 3]} : (f32x4){a0[4 * g], a0[4 * g + 1], a0[4 * g + 2], a0[4 * g + 3]}) * rs;
                ss += (v[g].x * v[g].x + v[g].y * v[g].y) + (v[g].z * v[g].z + v[g].w * v[g].w); }
            if (reg < 3) {
                ss += __shfl_xor(ss, 32);
#pragma unroll
                for (int g = 0; g < 4; ++g) { u32x2 w; w.x = pk2(v[g].x, v[g].y); w.y = pk2(v[g].z, v[g].w); *(u32x2*)(CQB + (size_t)row * QL + c0 + 8 * g) = w; }
                if (h == 0) ssqq[(size_t)row * 16 + reg * 4 + wn] = ss;
            } else if (reg < 5) {
#pragma unroll
                for (int g = 0; g < 4; ++g) *(f32x4*)(CKV + (size_t)row * CKVW + (c0 - 384) + 8 * g) = v[g];
            } else if (wn == 0) {
#pragma unroll
                for (int g = 0; g < 4; ++g) *(f32x4*)(CKV + (size_t)row * CKVW + 256 + 4 * h + 8 * g) = v[g];
            }
        }
    }
};
struct SEpiQabs {
    const float* ssqq; const float* rope; bf16_t* O; float qscale;
    DI void operator()(const f32x16& a0, const f32x16& a1, int rl, int ni, int wn, int h) const {
        const float rs = row_rstd(ssqq, TP + rl, 3, 1.0f / QL) * qscale; const int pos = 4096 + (rl & 15);
#pragma unroll
        for (int blk = 0; blk < 2; ++blk) {
            const int g32 = ni * 8 + blk * 4 + wn; float v[16];
#pragma unroll
            for (int i = 0; i < 16; ++i) v[i] = (blk ? a1[i] : a0[i]) * rs;
            if (g32 % 9 == 8) {
#pragma unroll
                for (int i = 0; i < 8; ++i) { const int f = crow(i, h); const float cs = rope[(size_t)pos * 32 + f], sn = rope[(size_t)pos * 32 + 16 + f];
                    const float x1 = v[i], x2 = v[i + 8]; v[i] = x1 * cs - x2 * sn; v[i + 8] = x1 * sn + x2 * cs; }
            }
            bf16_t* o = O + (size_t)rl * 4608 + g32 * 32 + 4 * h;
#pragma unroll
            for (int g = 0; g < 4; ++g) { u32x2 w; w.x = pk2(v[4 * g], v[4 * g + 1]); w.y = pk2(v[4 * g + 2], v[4 * g + 3]); *(u32x2*)(o + 8 * g) = w; }
        }
    }
};
struct SEpiKV {
    const float* ssqx; bf16_t* KS; float* out;
    DI void operator()(const f32x16& a0, const f32x16& a1, int rl, int ni, int wn, int h) const {
        const float rs = srow_rstd(ssqx, rl); const int b = rl >> 4, s = rl & 15;
#pragma unroll
        for (int blk = 0; blk < 2; ++blk)
#pragma unroll
            for (int g = 0; g < 4; ++g) { const int c = blk * 128 + 32 * wn + 4 * h + 8 * g;
                const f32x4 v = (blk ? (f32x4){a1[4 * g], a1[4 * g + 1], a1[4 * g + 2], a1[4 * g + 3]} : (f32x4){a0[4 * g], a0[4 * g + 1], a0[4 * g + 2], a0[4 * g + 3]}) * rs;
                *(f32x4*)(out + (ni ? O_VS : O_KS) + (size_t)rl * 256 + c) = v;
                u32x2 w; w.x = pk2(v.x, v.y); w.y = pk2(v.z, v.w); *(u32x2*)(KS + ((size_t)b * 192 + 128 + s) * 512 + ni * 256 + c) = w; }
    }
};
struct SEpiRowScale {
    const float* ssqs; float oscale; bf16_t* O;
    DI void operator()(const f32x16& a0, int rl, int ni, int wn, int h) const {
        const int row = TP + rl; const float rs = srow_rstd(ssqs, rl) * oscale;
#pragma unroll
        for (int g = 0; g < 4; ++g) { u32x2 w; const int i = 4 * g; w.x = pk2(a0[i] * rs, a0[i + 1] * rs); w.y = pk2(a0[i + 2] * rs, a0[i + 3] * rs);
            *(u32x2*)(O + (size_t)row * DM + ni * 128 + 32 * wn + 4 * h + 8 * g) = w; }
    }
};
template <class Epi>
DI void sgemm64_phase(lds_u8* lds, const bf16_t* A, int lda, const bf16_t* Bt, int ldb, int K, int nN64, int G, int bid, const Epi& E) {
    constexpr int BKS = 256, PB = BKS * 2 + 16, TA = 32 * PB, TB = TA + 64 * PB, RED = 2 * TB;
    static_assert(RED + 32768 <= LDS_SLOT, "LDS");
    const int tid = otid(), lane = tid & 63, wave = __builtin_amdgcn_readfirstlane(tid >> 6), r = lane & 31, h = lane >> 5, cb = wave & 1, ks = wave >> 1;
    const int ntiles = 16 * nN64, nk = K / BKS;
    for (int t = G - 1 - bid; t < ntiles; t += G) {
        const int mi = t & 15, ni = t >> 4;
        const bf16_t* Ap = A + (size_t)(mi * 32 + (tid >> 5)) * lda + (tid & 31) * 8;
        const bf16_t* Bp = Bt + (size_t)(ni * 64 + (tid >> 5)) * ldb + (tid & 31) * 8;
        f32x16 acc;
#pragma unroll
        for (int i = 0; i < 16; ++i) acc[i] = 0.f;
        u32x4 ra[4][2], rb[4][4];
#define SG_LOAD(s, kt) do { _Pragma("unroll") for (int i_ = 0; i_ < 2; ++i_) ra[s][i_] = *(const u32x4*)(Ap + (size_t)i_ * 16 * lda + (kt) * BKS); \
        _Pragma("unroll") for (int i_ = 0; i_ < 4; ++i_) rb[s][i_] = *(const u32x4*)(Bp + (size_t)i_ * 16 * ldb + (kt) * BKS); } while (0)
#define SG_STORE(s, buf) do { lds_u8* b_ = lds + (buf) * TB + (tid >> 5) * PB + (tid & 31) * 16; \
        _Pragma("unroll") for (int i_ = 0; i_ < 2; ++i_) *(LAS u32x4*)(b_ + i_ * 16 * PB) = ra[s][i_]; \
        _Pragma("unroll") for (int i_ = 0; i_ < 4; ++i_) *(LAS u32x4*)(b_ + TA + i_ * 16 * PB) = rb[s][i_]; } while (0)
#pragma unroll
        for (int s = 0; s < 4; ++s) if (s < nk) SG_LOAD(s, s);
        for (int kt0 = 0; kt0 < nk; kt0 += 4) {
#pragma unroll
            for (int s = 0; s < 4; ++s) {
                const int kt = kt0 + s;
                if (kt < nk) {
                    const int buf = s & 1;
                    SG_STORE(s, buf);
                    if (kt + 4 < nk) SG_LOAD(s, kt + 4);
                    __syncthreads();
                    const lds_u8* Aa = lds + buf * TB + r * PB + ks * 128 + h * 16;
                    const lds_u8* Bb = lds + buf * TB + TA + (32 * cb + r) * PB + ks * 128 + h * 16;
#pragma unroll
                    for (int j = 0; j < 4; ++j) { const bf16x8 af = *(const LAS bf16x8*)(Aa + j * 32), w0 = *(const LAS bf16x8*)(Bb + j * 32); acc = MFMA32(w0, af, acc); }
                }
            }
        }
        __syncthreads();
#undef SG_LOAD
#undef SG_STORE
        LAS f32x4* red = (LAS f32x4*)(lds + RED) + ((cb * 4 + ks) * 64 + lane) * 4;
        if (ks != 0) {
#pragma unroll
            for (int q = 0; q < 4; ++q) red[q] = (f32x4){acc[4 * q], acc[4 * q + 1], acc[4 * q + 2], acc[4 * q + 3]};
        }
        __syncthreads();
        if (ks == 0) {
#pragma unroll
            for (int o = 1; o < 4; ++o)
#pragma unroll
                for (int q = 0; q < 4; ++q) { const f32x4 v = red[o * 64 * 4 + q]; acc[4 * q] += v.x; acc[4 * q + 1] += v.y; acc[4 * q + 2] += v.z; acc[4 * q + 3] += v.w; }
            E(acc, mi * 32 + r, ni >> 1, (ni & 1) * 2 + cb, h);
        }
        __syncthreads();
    }
}
template <class Epi>
DI void sgemm128_phase(lds_u8* lds, const bf16_t* A, int lda, const bf16_t* Bt, int ldb, int K, int nN  , int G, int bid, const Epi& E) {
    constexpr int PB = 144, TA = 64 * PB, TB = TA + 128 * PB;
    const int tid = otid(), lane = tid & 63, wave = __builtin_amdgcn_readfirstlane(tid >> 6), r = lane & 31, h = lane >> 5, wm = wave >> 2, wn = wave & 3;
    const int ntiles = 8 * nN, nk = K / 64;
    for (int t = G - 1 - bid; t < ntiles; t += G) {
        const int mi = t & 7, ni = t >> 3;
        const bf16_t* Ap = A + (size_t)(mi * 64 + (tid >> 3)) * lda + (tid & 7) * 8;
        const bf16_t* Bp = Bt + (size_t)(ni * 128 + (tid >> 3)) * ldb + (tid & 7) * 8;
        f32x16 acc0;
#pragma unroll
        for (int i = 0; i < 16; ++i) acc0[i] = 0.f;
        u32x4 ra[4], rb[4][2];
#define SG_LOAD(s, kt) do { ra[s] = *(const u32x4*)(Ap + (kt) * 64); _Pragma("unroll") for (int i_ = 0; i_ < 2; ++i_) rb[s][i_] = *(const u32x4*)(Bp + (size_t)i_ * 64 * ldb + (kt) * 64); } while (0)
#define SG_STORE(s, buf) do { lds_u8* b_ = lds + (buf) * TB + (tid >> 3) * PB + (tid & 7) * 16; *(LAS u32x4*)b_ = ra[s]; \
        _Pragma("unroll") for (int i_ = 0; i_ < 2; ++i_) *(LAS u32x4*)(b_ + TA + i_ * 64 * PB) = rb[s][i_]; } while (0)
#pragma unroll
        for (int s = 0; s < 4; ++s) if (s < nk) SG_LOAD(s, s);
        for (int kt0 = 0; kt0 < nk; kt0 += 4) {
#pragma unroll
            for (int s = 0; s < 4; ++s) {
                const int kt = kt0 + s;
                if (kt < nk) {
                    const int buf = s & 1;
                    SG_STORE(s, buf);
                    if (kt + 4 < nk) SG_LOAD(s, kt + 4);
                    __syncthreads();
                    const lds_u8* Aa = lds + buf * TB + (32 * wm + r) * PB + h * 16;
                    const lds_u8* Bb = lds + buf * TB + TA + (32 * wn + r) * PB + h * 16;
#pragma unroll
                    for (int ks = 0; ks < 4; ++ks) {
                        const bf16x8 af = *(const LAS bf16x8*)(Aa + ks * 32), w0 = *(const LAS bf16x8*)(Bb + ks * 32);
                        acc0 = MFMA32(w0, af, acc0);
                    }
                }
            }
        }
        __syncthreads();
#undef SG_LOAD
#undef SG_STORE
        E(acc0, mi * 64 + 32 * wm + r, ni, wn, h);
    }
}

DI void tr_item(const float* W, int ldw, const float* gain, bf16_t* WT, int ldo, int mode, int row_off, LAS float* scr, int kb, int nb, int lane) {
    const int k0 = 64 * kb, n0 = 32 * nb;
#pragma unroll 16
    for (int i = 0; i < 32; ++i) { const int kk = 2 * i + (lane >> 5); float v = W[(size_t)(k0 + kk) * ldw + n0 + (lane & 31)]; if (gain) v *= gain[k0 + kk]; scr[kk * 33 + (lane & 31)] = v; }
    asm volatile("s_waitcnt lgkmcnt(0)" ::: "memory");
    const int c = lane & 7;
#pragma unroll
    for (int j = 0; j < 4; ++j) { const int n = (lane >> 3) + 8 * j; const LAS float* s = scr + (8 * c) * 33 + n;
        u32x4 o; o.x = pk2(s[0 * 33], s[1 * 33]); o.y = pk2(s[2 * 33], s[3 * 33]); o.z = pk2(s[4 * 33], s[5 * 33]); o.w = pk2(s[6 * 33], s[7 * 33]);
        const int nn = n0 + n; const int orow = (mode == 0) ? row_off + nn : (mode <= 2) ? ((nn >> 7) * 256 + (nn & 127) + (mode == 2 ? 128 : 0)) : ((nn >> 6) * 128 + (nn & 63) + (mode == 4 ? 64 : 0));
        *(u32x4*)(WT + (size_t)orow * ldo + k0 + 8 * c) = o; }
    asm volatile("s_waitcnt lgkmcnt(0)" ::: "memory");
}
DI void tr64_item(const float* W, int ldw, const float* gain, bf16_t* WT, int ldo, int mode, LAS float* scr, int kb, int nb, int lane) {
    const int k0 = 64 * kb, n0 = 64 * nb;
    float v[64];
    const float* src = W + (size_t)k0 * ldw + n0 + lane;
#pragma unroll
    for (int i = 0; i < 64; ++i) v[i] = src[(size_t)i * ldw];
    if (gain) {
#pragma unroll
        for (int i = 0; i < 64; ++i) v[i] *= gain[k0 + i];
    }
#pragma unroll
    for (int i = 0; i < 64; ++i) scr[i * 65 + lane] = v[i];
    asm volatile("s_waitcnt lgkmcnt(0)" ::: "memory");
    const int c = lane & 7;
#pragma unroll
    for (int j = 0; j < 8; ++j) { const int n = (lane >> 3) + 8 * j; const LAS float* s = scr + (8 * c) * 65 + n;
        u32x4 o; o.x = pk2(s[0 * 65], s[1 * 65]); o.y = pk2(s[2 * 65], s[3 * 65]); o.z = pk2(s[4 * 65], s[5 * 65]); o.w = pk2(s[6 * 65], s[7 * 65]);
        const int nn = n0 + n; const int orow = (mode == 0) ? nn : (mode <= 2) ? ((nn >> 7) * 256 + (nn & 127) + (mode == 2 ? 128 : 0)) : ((nn >> 6) * 128 + (nn & 63) + (mode == 4 ? 64 : 0));
        *(u32x4*)(WT + (size_t)orow * ldo + k0 + 8 * c) = o; }
    asm volatile("s_waitcnt lgkmcnt(0)" ::: "memory");
}
DI void tr_matrix(const float* W, int K, int N, const float* gain, bf16_t* WT, int ldo, int mode, int row_off, LAS float* scr, int gw, int NGW, int lane) {
    const int nblk = N / 32, nitems = (K / 64) * nblk;
    for (int it = gw; it < nitems; it += NGW) tr_item(W, N, gain, WT, ldo, mode, row_off, scr, it / nblk, it % nblk, lane);
}


#define XB_TMO      128
#define XB_XCNT(j)  (256  + 64 * (j))
#define XB_XSUB(j)  (1280 + 64 * (j))
#define XB_XGEN(j)  (2304 + 64 * (j))
#define XB_TOP      3328
#define XB_TOPGEN   3392
#define XB_SPIN_CAP (1u << 22)
DI unsigned xb_ld(unsigned* p)              { return __hip_atomic_load(p, __ATOMIC_RELAXED, __HIP_MEMORY_SCOPE_AGENT); }
DI unsigned xb_add(unsigned* p, unsigned v) { return __hip_atomic_fetch_add(p, v, __ATOMIC_RELAXED, __HIP_MEMORY_SCOPE_AGENT); }
DI unsigned xb_xcc_id() { return (unsigned)__builtin_amdgcn_s_getreg((3 << 11) | 20) & 0xFu; }
#define XB_SPIN(cond, bar) do { unsigned _sp = 0; while (cond) { __builtin_amdgcn_s_sleep(1); \
    if ((++_sp & 255u) == 0u) { if (xb_ld(&(bar)[XB_TMO])) break; if (_sp > XB_SPIN_CAP) { atomicAdd(&(bar)[XB_TMO], 1u); break; } } } } while (0)
struct XcdBarrier { unsigned* bar; unsigned x; volatile LAS unsigned* st; };
DI XcdBarrier xcd_barrier_post(unsigned* bar, volatile LAS unsigned* st) {
    XcdBarrier b; b.bar = bar; b.x = xb_xcc_id(); b.st = st;
    if (threadIdx.x == 0) (void)xb_add(&bar[XB_XCNT(b.x)], 1u);
    return b;
}
DI void xcd_barrier_complete(unsigned* bar, unsigned x, unsigned& nloc, unsigned& nx) {
    const unsigned G = gridDim.x * gridDim.y * gridDim.z;
    unsigned sum, cnt, mine, sp = 0u;
    for (;;) {
        sum = 0u; cnt = 0u; mine = 0u;
#pragma unroll
        for (unsigned j = 0; j < 16; ++j) { const unsigned c = xb_ld(&bar[XB_XCNT(j)]); sum += c; cnt += (c > 0u) ? 1u : 0u; mine = (j == x) ? c : mine; }
        if (sum == G) break;
        __builtin_amdgcn_s_sleep(1);
        if ((++sp & 255u) == 0u) { if (xb_ld(&bar[XB_TMO])) break; if (sp > XB_SPIN_CAP) { atomicAdd(&bar[XB_TMO], 1u); break; } }
    }
    nloc = mine > 0u ? mine : 1u; nx = cnt > 0u ? cnt : 1u;
}
DI void xcd_barrier(const XcdBarrier& b) {
    asm volatile("s_waitcnt vmcnt(0)" ::: "memory");
    __syncthreads();
    if (threadIdx.x == 0) {
        unsigned* bar = b.bar;
        __builtin_amdgcn_s_waitcnt(0);
        unsigned nloc = b.st[0], nx = b.st[1];
        if (nloc == 0u) { xcd_barrier_complete(bar, b.x, nloc, nx); b.st[0] = nloc; b.st[1] = nx; }
        const unsigned old = xb_add(&bar[XB_XSUB(b.x)], 1u);
        const unsigned gen = old / nloc;
        if (old + 1u == (gen + 1u) * nloc) {
            __builtin_amdgcn_fence(__ATOMIC_RELEASE, "agent");
            asm volatile("s_waitcnt vmcnt(0)" ::: "memory");
            const unsigned og = xb_add(&bar[XB_TOP], 1u);
            const unsigned tg = og / nx;
            if (og + 1u == (tg + 1u) * nx) xb_add(&bar[XB_TOPGEN], 1u);
            else XB_SPIN(xb_ld(&bar[XB_TOPGEN]) == tg, bar);
            __builtin_amdgcn_fence(__ATOMIC_ACQUIRE, "agent");
            xb_add(&bar[XB_XGEN(b.x)], 1u);
            asm volatile("s_waitcnt vmcnt(0)" ::: "memory");
        } else {
            XB_SPIN(xb_ld(&bar[XB_XGEN(b.x)]) == gen, bar);
            __builtin_amdgcn_fence(__ATOMIC_ACQUIRE, "agent");
            asm volatile("s_waitcnt vmcnt(0)" ::: "memory");
        }
    }
    __syncthreads();
}

struct Params {
    const float* in[30];
    float* out;
    unsigned char* ws;
    float inv_freq[16];
};

#define WSP(T_, off_) ((T_*)(p.ws + (off_)))
#define P_WGU WSP(bf16_t, WS_WGU)
#define P_WD WSP(bf16_t, WS_WD)
#define P_W3 WSP(bf16_t, WS_W3)
#define P_WUQT WSP(bf16_t, WS_WUQT)
#define P_WABST WSP(bf16_t, WS_WABST)
#define P_W5T WSP(bf16_t, WS_WUKT)
#define P_WOT WSP(bf16_t, WS_WOT)
#define P_WOVT WSP(bf16_t, WS_WOVT)
#define P_WKVT WSP(bf16_t, WS_WKVT)
#define P_WQST WSP(bf16_t, WS_WQST)
#define P_WOST WSP(bf16_t, WS_WOST)
#define P_ROPE WSP(float, WS_ROPE)
#define P_BT WSP(float, WS_BT)
#define P_XB WSP(bf16_t, WS_XB)
#define P_SSQX WSP(float, WS_SSQX)
#define P_SSQQ WSP(float, WS_SSQQ)
#define P_SSQL WSP(float, WS_SSQL)
#define P_SSQS WSP(float, WS_SSQS)
#define P_ACT WSP(bf16_t, WS_ACT)
#define P_QB WSP(bf16_t, WS_QB)
#define P_QS WSP(bf16_t, WS_QS)
#define P_CQB WSP(bf16_t, WS_CQB)
#define P_CKV WSP(float, WS_CKV)
#define P_LATB WSP(bf16_t, WS_LATB)
#define P_OB WSP(bf16_t, WS_OB)
#define P_QA WSP(bf16_t, WS_QA)
#define P_KNV WSP(bf16_t, WS_KNV)
#define P_KRB WSP(bf16_t, WS_KRB)
#define P_OA WSP(bf16_t, WS_OA)
#define P_KVSB WSP(bf16_t, WS_KVSB)
#define P_KS WSP(bf16_t, WS_KS)
#define P_KC WSP(bf16_t, WS_KC)
#define P_CTL WSP(unsigned, WS_CTL)

__global__ void __launch_bounds__(NTHREADS) yoco_fwd(Params p) {
    extern __shared__ __attribute__((aligned(16))) unsigned char lds_raw[];
    cg::grid_group grid = cg::this_grid();
    lds_u8* lds = (lds_u8*)lds_raw;
    const int G = gridDim.x, bid = blockIdx.x, NGW = G * NWAVES;
#define PHASE_IDS const int tid = otid(), lane = tid & 63, wave = __builtin_amdgcn_readfirstlane(tid >> 6), gw = bid * NWAVES + wave; (void)lane; (void)gw
    float* X = p.out;
    LAS int* slot = (LAS int*)(lds + LDS_SLOT);
    volatile LAS unsigned* bst = (volatile LAS unsigned*)(lds + LDS_SLOT + 16);
    if (threadIdx.x == 0) { bst[0] = 0u; bst[1] = 0u; }
    __syncthreads();
    const XcdBarrier xbar = xcd_barrier_post(P_CTL + 4096, bst);
#define GSYNC() xcd_barrier(xbar)

    {
        PHASE_IDS;
        LAS float* scr = (LAS float*)(lds + wave * 16640);
        {
            const int sgw = gw, SNGW = NGW;
            for (int row0 = sgw * 2; row0 < TT; row0 += SNGW * 2) {
                f32x4 v[2][4];
#pragma unroll
                for (int q = 0; q < 2; ++q) { const int row = row0 + q; const float* src = row < TP ? p.in[0] + (size_t)row * DM : p.in[1] + (size_t)(row - TP) * DM;
#pragma unroll
                    for (int j = 0; j < 4; ++j) v[q][j] = *(const f32x4*)(src + j * 256 + lane * 4); }
#pragma unroll
                for (int q = 0; q < 2; ++q) { const int row = row0 + q; float ss = 0.f;
#pragma unroll
                    for (int j = 0; j < 4; ++j) { const f32x4 t = v[q][j]; u32x2 w; w.x = pk2(t.x, t.y); w.y = pk2(t.z, t.w); *(u32x2*)(P_XB + (size_t)row * DM + j * 256 + lane * 4) = w; ss += (t.x * t.x + t.y * t.y) + (t.z * t.z + t.w * t.w); }
                    ss = wave_sum(ss);
                    if (row < TP) { if (lane < 16) P_SSQX[(size_t)row * 16 + lane] = (lane == 0) ? ss : 0.f; }
                    else if (lane < 32) P_SSQS[(size_t)(row - TP) * 32 + lane] = (lane == 0) ? ss : 0.f; }
            }
            {
                constexpr int I_F = 704, I_DQ = 96, I_UQ = 144, I_UK = 64, I_O = 256, I_KV = 128;
                constexpr int NIT = 12 * I_F + I_DQ + I_UQ + 2 * I_UK + 3 * I_O + I_KV;
                for (int it = sgw; it < NIT; it += SNGW) {
                    int rI = it;
                    const float* W; const float* gain = nullptr; bf16_t* WT; int N_, ldo, mode = 0;
                    if (rI < 12 * I_F) { const int m = rI / I_F; rI -= m * I_F; const int l = m / 6, t = m % 6, f = 2 * l + (t >= 3 ? 1 : 0), tt = t % 3;
                        if (tt == 2) { W = p.in[t == 2 ? 9 : 14] + (size_t)l * FF * DM; N_ = DM; WT = P_WD + (size_t)f * DM * FF; ldo = FF; }
                        else { W = p.in[(t >= 3 ? 12 : 7) + tt] + (size_t)l * DM * FF; N_ = FF; gain = p.in[t >= 3 ? 11 : 6] + l * DM; WT = P_WGU + (size_t)f * FF2 * DM; ldo = DM; mode = 1 + tt; }
                    } else { rI -= 12 * I_F;
                        if (rI < I_DQ) { W = p.in[15]; N_ = QL; gain = p.in[10]; WT = P_W3; ldo = DM; }
                        else if ((rI -= I_DQ) < I_UQ) { W = p.in[17]; N_ = 1536; gain = p.in[16]; WT = P_WUQT; ldo = QL; }
                        else if ((rI -= I_UQ) < I_UK) { W = p.in[20]; N_ = 1024; gain = p.in[19]; WT = P_W5T; ldo = KVL; mode = 3; }
                        else if ((rI -= I_UK) < I_UK) { W = p.in[21]; N_ = 1024; gain = p.in[19]; WT = P_W5T; ldo = KVL; mode = 4; }
                        else if ((rI -= I_UK) < I_O) { W = p.in[22]; N_ = DM; WT = P_WOT; ldo = DM; }
                        else if ((rI -= I_O) < I_KV) { W = p.in[24]; N_ = 512; gain = p.in[23]; WT = P_WKVT; ldo = DM; }
                        else if ((rI -= I_KV) < I_O) { W = p.in[25]; N_ = DM; gain = p.in[10] + DM; WT = P_WQST; ldo = DM; }
                        else { rI -= I_O; W = p.in[27]; N_ = DM; WT = P_WOST; ldo = DM; }
                    }
                    const int nblk = N_ / 64;
                    tr64_item(W, N_, gain, WT, ldo, mode, scr, rI / nblk, rI % nblk, lane);
                }
            }
            tr_matrix(p.in[18], DM, CKVW, p.in[10], P_W3, DM, 0, 384, scr, sgw, SNGW, lane);
            for (int i = sgw * 64 + lane; i < 96 * DM / 8; i += SNGW * 64) *(u32x4*)(P_W3 + (size_t)672 * DM + (size_t)i * 8) = (u32x4){0u, 0u, 0u, 0u};
            for (int rw = sgw; rw < 32 * 128; rw += SNGW) {
                const int b = rw >> 7, kk = rw & 127; bf16_t* dst = P_KS + ((size_t)b * 192 + kk) * 512;
                const f32x4 v = *(const f32x4*)(p.in[4] + (size_t)rw * 256 + lane * 4); u32x2 w; w.x = pk2(v.x, v.y); w.y = pk2(v.z, v.w); *(u32x2*)(dst + lane * 4) = w;
                const f32x4 q = *(const f32x4*)(p.in[5] + (size_t)rw * 256 + lane * 4); u32x2 w2; w2.x = pk2(q.x, q.y); w2.y = pk2(q.z, q.w); *(u32x2*)(dst + 256 + lane * 4) = w2;
            }
        }
        {
            const int cgw = gw, CNGW = NGW;
            for (int i = cgw * 64 + lane; i < KCL * 16; i += CNGW * 64) { const int pos = i >> 4, f = i & 15; const float ang = (float)pos * p.inv_freq[f];
                P_ROPE[(size_t)pos * 32 + f] = cosf(ang); P_ROPE[(size_t)pos * 32 + 16 + f] = sinf(ang); }
            for (int i = cgw * 64 + lane; i < 16 * 256; i += CNGW * 64) { const int hh = i >> 8, idx = i & 255; const int rel = idx - 191; const int n = rel < 0 ? -rel : rel;
                const float nf = (float)(n > 1 ? n : 1);
                int large = 8 + (int)(logf(nf / 8.0f) / 2.7725887298583984f * 8.0f); large = large < 15 ? large : 15;
                const int bucket = (rel > 0 ? 16 : 0) + (n < 8 ? n : large);
                P_BT[i] = p.in[28][bucket * 16 + hh] * LOG2E; }
            for (int it = cgw; it < 16 * 16 * 8; it += CNGW) {
                const int hh = it >> 7, nb = (it >> 3) & 15, cg_ = it & 7; const int n = nb * 64 + lane;
#pragma unroll
                for (int q = 0; q < 8; ++q) { const int idx = q * 64 + lane, cc = idx >> 4, j4 = idx & 15;
                    *(LAS f32x4*)(scr + cc * 64 + j4 * 4) = *(const f32x4*)(p.in[21] + (size_t)(cg_ * 32 + cc) * 1024 + hh * 64 + j4 * 4); }
                float bw[64];
                const float* bo = p.in[22] + (size_t)(hh * 64) * 1024 + n;
#pragma unroll
                for (int j = 0; j < 64; ++j) bw[j] = bo[(size_t)j * 1024];
                asm volatile("s_waitcnt lgkmcnt(0)" ::: "memory");
                for (int c8 = 0; c8 < 4; ++c8) {
                    float s[8];
#pragma unroll
                    for (int cc = 0; cc < 8; ++cc) { const LAS f32x4* av = (const LAS f32x4*)(scr + (c8 * 8 + cc) * 64); float acc = 0.f;
#pragma unroll
                        for (int j = 0; j < 16; ++j) { const f32x4 a4 = av[j]; acc += (bw[4 * j] * a4.x + bw[4 * j + 1] * a4.y) + (bw[4 * j + 2] * a4.z + bw[4 * j + 3] * a4.w); }
                        s[cc] = acc; }
                    u32x4 o; o.x = pk2(s[0], s[1]); o.y = pk2(s[2], s[3]); o.z = pk2(s[4], s[5]); o.w = pk2(s[6], s[7]);
                    *(u32x4*)(P_WOVT + (size_t)n * 4096 + hh * 256 + cg_ * 32 + c8 * 8) = o;
                }
                asm volatile("s_waitcnt lgkmcnt(0)" ::: "memory");
            }
            for (int it = cgw; it < 16 * 6 * 33; it += CNGW) {
                const int hh = it / 198, rem = it % 198, kb = rem / 33, cq = rem % 33; const int k = kb * 64 + lane;
                const float* aq = p.in[17] + (size_t)k * 1536 + hh * 96; const float gq = p.in[16][k];
                if (cq < 32) {
                    float a[64];
#pragma unroll
                    for (int j = 0; j < 16; ++j) { const f32x4 t = *(const f32x4*)(aq + 4 * j); a[4 * j] = t.x; a[4 * j + 1] = t.y; a[4 * j + 2] = t.z; a[4 * j + 3] = t.w; }
#pragma unroll
                    for (int cc = 0; cc < 8; ++cc) { const int c = cq * 8 + cc; const float* bk = p.in[20] + (size_t)c * 1024 + hh * 64; float s = 0.f;
#pragma unroll
                        for (int j = 0; j < 64; ++j) s += a[j] * bk[j];
                        P_WABST[(size_t)(hh * 288 + c) * QL + k] = f2bf(s * gq); }
                } else {
                    for (int rr = 0; rr < 32; ++rr) P_WABST[(size_t)(hh * 288 + 256 + rr) * QL + k] = f2bf(aq[64 + rr] * gq);
                }
            }
        }
    }
    grid.sync();

    pg8::StaticOrder S;
#define GEMM_UP(f) do { { pg8::Gemm g{P_XB, P_WGU + (size_t)(f) * FF2 * DM, DM, DM, DM}; S.init(TT, FF2, G, bid); pg8::EpiSwiGLU E{P_ACT, P_SSQX, P_SSQS}; pg8::gemm_phase(lds, g, S, E); } } while (0)
#define GEMM_DOWN(f) do { { pg8::Gemm g{P_ACT, P_WD + (size_t)(f) * DM * FF, FF, FF, FF}; S.init(TP, DM, G, bid); pg8::EpiResid E{(f) == 0 ? p.in[0] : X, X, P_XB, P_SSQX, 0.5f, 0}; pg8::gemm_phase(lds, g, S, E); } \
    { SEpiResid E2{(f) == 0 ? p.in[1] - (size_t)TP * DM : X, X, P_XB, P_SSQS, 0.5f}; sgemm64_phase(lds, P_ACT + (size_t)TP * FF, FF, P_WD + (size_t)(f) * DM * FF, FF, FF, DM / 64, G, bid, E2); } } while (0)

    GEMM_UP(0); GSYNC();
    GEMM_DOWN(0); GSYNC();
    { pg8::Gemm g{P_XB, P_W3, DM, DM, DM}; S.init(TP, 768, G, bid); pg8::EpiG3 E{P_SSQX, P_CQB, P_CKV, P_LATB, P_SSQQ, P_SSQL}; pg8::gemm_phase(lds, g, S, E); }
    { SEpiG3 E2{P_SSQS, P_CQB, P_CKV, P_SSQQ}; sgemm_phase(lds, P_XB + (size_t)TP * DM, DM, P_W3, DM, DM, 3, G, bid, E2); }
    GSYNC();
    {
        { PHASE_IDS;
        for (int row0 = gw * 2; row0 < TT; row0 += NGW * 2) {
            f32x4 vv[2]; float x1v[2], x2v[2];
#pragma unroll
            for (int q = 0; q < 2; ++q) { const float* ck = P_CKV + (size_t)(row0 + q) * CKVW; vv[q] = *(const f32x4*)(ck + lane * 4); x1v[q] = ck[256 + (lane & 15)]; x2v[q] = ck[272 + (lane & 15)]; }
#pragma unroll
            for (int q = 0; q < 2; ++q) {
            const int row = row0 + q; const f32x4 v = vv[q];
            const float ss = wave_sum((v.x * v.x + v.y * v.y) + (v.z * v.z + v.w * v.w)); const float rs = rsqrtf(ss * (1.0f / KVL) + RMS_EPS);
            const f32x4 gn = *(const f32x4*)(p.in[19] + lane * 4); const f32x4 o = v * rs * gn;
            const bool smp = row >= TP; const int sr = row - TP;
            *(f32x4*)(p.out + (smp ? O_LATS + (size_t)sr * 256 : O_LATP + (size_t)row * 256) + lane * 4) = o;
            const int pos = smp ? 4096 + (sr & 15) : (row & 4095);
            float kr = 0.f;
            if (lane < 32) { const int f = lane & 15; const float x1 = x1v[q], x2 = x2v[q];
                const float cs = P_ROPE[(size_t)pos * 32 + f], sn = P_ROPE[(size_t)pos * 32 + 16 + f];
                kr = lane < 16 ? x1 * cs - x2 * sn : x1 * sn + x2 * cs;
                p.out[(smp ? O_ROPES + (size_t)sr * 32 : O_ROPEP + (size_t)row * 32) + lane] = kr; }
            if (!smp && lane < 32) P_KRB[(size_t)row * 32 + lane] = f2bf(kr);
            }
        } }
        const float qscale = 0.10206207261596577f * LOG2E;
        { pg8::Gemm g{P_CQB, P_WUQT, QL, QL, QL}; S.init(TP, 1536, G, bid); pg8::EpiQ E{P_SSQQ, P_ROPE, P_QB, 1536, 0, 0, 3, 2, qscale}; pg8::gemm_phase(lds, g, S, E); }
        { SEpiQabs E2{P_SSQQ, P_ROPE, P_QA, qscale}; sgemm_phase(lds, P_CQB + (size_t)TP * QL, QL, P_WABST, QL, QL, 18, G, bid, E2); }
        { pg8::Gemm g{P_LATB, P_W5T, KVL, KVL, KVL}; S.init(TP, 2048, G, bid); pg8::EpiRowScale E{P_SSQL, 2, 1.0f / KVL, 1.0f, P_KNV, 2048}; pg8::gemm_phase(lds, g, S, E); }
    }
    GSYNC();
    {
        PHASE_IDS;
        for (;;) {
            __syncthreads(); if (tid == 0) *slot = (int)atomicAdd(P_CTL + 0, 1u); __syncthreads();
            const int u = *slot; if (u >= 64 + 1024) break;
            const int r = lane & 31;
            if (u < 64) {
                const int b = u >> 1, hf = u & 1, qb = wave & 3, dh = wave >> 2; const int head = hf * 8 + qb * 2 + (r >> 4), s = r & 15;
                flash_abs_unit(lds, P_QA + (size_t)(b * 16 + s) * 4608 + head * 288, p.in[2] + (size_t)b * 4096 * 256, p.in[3] + (size_t)b * 4096 * 32,
                    p.out + O_LATS + (size_t)b * 16 * 256, p.out + O_ROPES + (size_t)b * 16 * 32, dh * 128, P_OA + (size_t)(b * 16 + s) * 4096 + head * 256);
            } else {
                const int u2 = u - 64, i = 15 - (u2 >> 6), bh = u2 & 63, b = bh >> 4, hh = bh & 15; const int q = i * 256 + wave * 32 + r;
                flash_unit<96, 160, 4, 64, 64, 2, 2, false>(lds, P_QB + (size_t)(b * SEQ + q) * 1536 + hh * 96, P_KNV + (size_t)b * SEQ * 2048 + hh * 128, 2048, 16, P_KRB + (size_t)b * SEQ * 32, 32,
                    0, 0, 4 * (i + 1), 4 * i + (wave >> 1) + 1, 1 << 30, -1e30f, 0.f, (const LAS float*)lds, 0,
                    P_OB + (size_t)(b * SEQ + q) * DM + hh * 64, true);
            }
        }
    }
    GSYNC();
    { pg8::Gemm g{P_OB, P_WOT, DM, DM, DM}; S.init(TP, DM, G, bid); pg8::EpiResid E{X, X, P_XB, P_SSQX, 1.0f, 0}; pg8::gemm_phase(lds, g, S, E); }
    { SEpiResid E2{X, X, P_XB, P_SSQS, 1.0f}; sgemm64_phase(lds, P_OA, 4096, P_WOVT, 4096, 4096, 16, G, bid, E2); }
    GSYNC();
    GEMM_UP(1); GSYNC();
    GEMM_DOWN(1); GSYNC();
    { pg8::Gemm g{P_XB, P_WKVT, DM, DM, DM}; S.init(TT, 512, G, G - 1 - bid); pg8::EpiKV E{P_SSQX, P_KVSB, P_KS, p.out, P_SSQS}; pg8::gemm_phase(lds, g, S, E); }
    GEMM_UP(2); GSYNC();
    GEMM_DOWN(2); GSYNC();
    { pg8::Gemm g{P_XB, P_WQST, DM, DM, DM}; S.init(TP, DM, G, bid); pg8::EpiRowScale E{P_SSQX, 4, 1.0f / DM, 0.125f * LOG2E, P_QS, DM}; pg8::gemm_phase(lds, g, S, E); }
    { SEpiRowScale E2{P_SSQS, 0.125f * LOG2E, P_QS}; sgemm64_phase(lds, P_XB + (size_t)TP * DM, DM, P_WQST, DM, DM, 16, G, bid, E2); }
    GSYNC();
    {
        PHASE_IDS;
        LAS float* btab = (LAS float*)(lds + 40960);
        int g4_loaded = -1;
        for (int u = bid; u < 1024 + 128; u += G) {
            const int r = lane & 31;
            int b, g4, c; bool smp;
            if (u < 1024) { smp = false; b = u >> 8; c = (u >> 2) & 63; g4 = u & 3; } else { smp = true; const int v = u - 1024; b = v >> 2; g4 = v & 3; c = 64; }
            if (g4 != g4_loaded) { __syncthreads(); for (int i = tid; i < 1024; i += NTHREADS) btab[i] = P_BT[(g4 * 4 + (i >> 8)) * 256 + (i & 255)]; g4_loaded = g4; }
            const int hh = g4 * 4 + (wave >> 1);
            const float sink = p.in[26][hh] * LOG2E;
            if (!smp) {
                const int qi = (wave & 1) * 32 + r; const size_t qrow = (size_t)b * SEQ + c * 64 + qi; const int j0 = c >= 2 ? 0 : 2 - c;
                const bf16_t* kv = P_KVSB + ((long)b * SEQ + (c - 2) * 64) * 512 + g4 * 64;
                flash_unit<64, 128, 4, 0, 64, 2, 2, true>(lds, P_QS + qrow * DM + hh * 64, kv, 512, 8, kv + 256, 512,
                    0, j0, 3, 3, 1 << 30, sink, (lane >> 5) == 0 ? 1.f : 0.f,
                    btab + (wave >> 1) * 256, 63 - qi, P_OB + qrow * DM + hh * 64, true);
            } else {
                const int qi = r & 15; const size_t qrow = (size_t)TP + b * 16 + qi;
                const bf16_t* kv = P_KS + (size_t)b * 192 * 512 + g4 * 64;
                flash_unit<64, 128, 4, 0, 64, 2, 2, true>(lds, P_QS + qrow * DM + hh * 64, kv, 512, 8, kv + 256, 512,
                    0, 0, 3, (wave & 1) ? 0 : 3, 144, sink, (lane >> 5) == 0 ? 1.f : 0.f,
                    btab + (wave >> 1) * 256, 63 - qi, P_OB + qrow * DM + hh * 64, (wave & 1) == 0 && r < 16);
            }
        }
    }
    GSYNC();
    { pg8::Gemm g{P_OB, P_WOST, DM, DM, DM}; S.init(TP, DM, G, bid); pg8::EpiResid E{X, X, P_XB, P_SSQX, 1.0f, 0}; pg8::gemm_phase(lds, g, S, E); }
    { SEpiResid E2{X, X, P_XB, P_SSQS, 1.0f}; sgemm64_phase(lds, P_OB + (size_t)TP * DM, DM, P_WOST, DM, DM, 16, G, bid, E2); }
    GSYNC();
    GEMM_UP(3); GSYNC();
    GEMM_DOWN(3); GSYNC();
    { PHASE_IDS;
    for (int row0 = gw * 2; row0 < TT; row0 += NGW * 2) {
        f32x4 v[2][4];
#pragma unroll
        for (int q = 0; q < 2; ++q)
#pragma unroll
            for (int j = 0; j < 4; ++j) v[q][j] = *(const f32x4*)(X + (size_t)(row0 + q) * DM + j * 256 + lane * 4);
#pragma unroll
        for (int q = 0; q < 2; ++q) { float ss = 0.f;
#pragma unroll
            for (int j = 0; j < 4; ++j) ss += (v[q][j].x * v[q][j].x + v[q][j].y * v[q][j].y) + (v[q][j].z * v[q][j].z + v[q][j].w * v[q][j].w);
            const float rs = rsqrtf(wave_sum(ss) * (1.0f / DM) + RMS_EPS);
#pragma unroll
            for (int j = 0; j < 4; ++j) { const f32x4 gn = *(const f32x4*)(p.in[29] + j * 256 + lane * 4); *(f32x4*)(X + (size_t)(row0 + q) * DM + j * 256 + lane * 4) = v[q][j] * rs * gn; } }
    } }
}

extern "C" void kernel_launch(void* const* d_in, const int* in_sizes, int n_in, void* d_out, int out_size, void* d_ws, size_t ws_size, hipStream_t stream) {
    static int grid = 0;
    if (grid == 0) {
        if (n_in != 30 || ws_size < WS_END) { fprintf(stderr, "kernel_launch: n_in %d ws %zu (need %zu)\n", n_in, ws_size, (size_t)WS_END); grid = -1; return; }
        int dev = 0, cus = 0, per_cu = 0;
        hipGetDevice(&dev);
        hipDeviceGetAttribute(&cus, hipDeviceAttributeMultiprocessorCount, dev);
        hipFuncSetAttribute((const void*)yoco_fwd, hipFuncAttributeMaxDynamicSharedMemorySize, LDS_BYTES);
        hipOccupancyMaxActiveBlocksPerMultiprocessor(&per_cu, (const void*)yoco_fwd, NTHREADS, LDS_BYTES);
        if (per_cu < 1) per_cu = 1;
        grid = cus;
        (void)hipGetLastError();
    }
    if (grid < 0) return;
    (void)hipMemsetAsync((char*)d_ws + WS_CTL, 0, CTL_BYTES, stream);
    Params p{};
    for (int i = 0; i < 30; ++i) p.in[i] = (const float*)d_in[i];
    p.out = (float*)d_out; p.ws = (unsigned char*)d_ws;
    for (int i = 0; i < 16; ++i) p.inv_freq[i] = (float)pow(10000.0, -(double)(2 * i) / 32.0);
    void* args[] = {&p};
    hipError_t e = hipLaunchCooperativeKernel((const void*)yoco_fwd, dim3(grid), dim3(NTHREADS), args, LDS_BYTES, stream);
    if (e != hipSuccess) fprintf(stderr, "cooperative launch failed: %s (grid %d)\n", hipGetErrorString(e), grid);
}
```
